# Optimizing an MI355X kernel written in HIP

```python
import jax, jax.numpy as jnp
from jax import lax
import numpy as np

D_MODEL = 1024
BATCH = 32
SEQ = 2048
DEPTH = 2

MLA_HEADS = 8
Q_LORA = 384
KV_LORA = 256
QK_NOPE = 64
QK_ROPE = 32
V_HEAD = 64
ROPE_THETA = 10000.0
Q_BLOCK = 128

SG_GROUPS = 8
SG_DIM = 512
SG_CHUNK = 128

RWKV_HEADS = 8
RWKV_HEAD = 64
RWKV_DIM = RWKV_HEADS * RWKV_HEAD
DECAY_LORA = 64
AAA_LORA = 64
GATE_LORA = 128
N_DIR = 2
GN_EPS = 64e-5

N_BRANCH = 3
BRANCH_DIM = 512
D_FF = -(-8 * D_MODEL // (3 * 256)) * 256
NORM_EPS = 1e-6

MLA_IN = Q_LORA + KV_LORA + QK_ROPE
SG_IN = 2 * SG_DIM
RWKV_IN = 3 * RWKV_DIM + N_DIR * DECAY_LORA + N_DIR * AAA_LORA + GATE_LORA
GATE_IN = N_BRANCH * D_MODEL
N_IN = MLA_IN + SG_IN + RWKV_IN + GATE_IN

kernel_name = "hybrid_mla_gmlp_rwkv7_encoder"


def rmsnorm(x, g):
    xf = x.astype(jnp.float32)
    y = xf * lax.rsqrt(jnp.mean(xf * xf, axis=-1, keepdims=True) + NORM_EPS)
    return (y * g.astype(jnp.float32)).astype(x.dtype)


def layernorm(x, g, b, eps=1e-5):
    xf = x.astype(jnp.float32)
    mu = jnp.mean(xf, axis=-1, keepdims=True)
    var = jnp.mean(jnp.square(xf - mu), axis=-1, keepdims=True)
    y = (xf - mu) * lax.rsqrt(var + eps)
    return (y * g.astype(jnp.float32) + b.astype(jnp.float32)).astype(x.dtype)


def rope_angles(positions):
    inv_freq = 1.0 / (ROPE_THETA ** (jnp.arange(0, QK_ROPE, 2, dtype=jnp.float32) / QK_ROPE))
    ang = positions.astype(jnp.float32)[..., None] * inv_freq
    return jnp.cos(ang), jnp.sin(ang)


def apply_rope(x, cos, sin):
    half = QK_ROPE // 2
    xf = x.astype(jnp.float32)
    x1, x2 = xf[..., :half], xf[..., half:]
    return jnp.concatenate([x1 * cos - x2 * sin, x1 * sin + x2 * cos], axis=-1).astype(x.dtype)


def mla_attention(cq, ckv, positions, q_norm_g, w_uq, kv_norm_g, w_ukv):
    B, S, _ = cq.shape
    q = (rmsnorm(cq, q_norm_g) @ w_uq).reshape(B, S, MLA_HEADS, QK_NOPE + QK_ROPE)
    q_nope, q_rope = q[..., :QK_NOPE], q[..., QK_NOPE:]
    c_kv, k_rope = ckv[..., :KV_LORA], ckv[..., KV_LORA:]
    kv = (rmsnorm(c_kv, kv_norm_g) @ w_ukv).reshape(B, S, MLA_HEADS, QK_NOPE + V_HEAD)
    k_nope, v = kv[..., :QK_NOPE], kv[..., QK_NOPE:]
    cos, sin = rope_angles(positions)
    q_rope = apply_rope(q_rope, cos[:, :, None], sin[:, :, None])
    k_rope = apply_rope(k_rope, cos, sin)
    scale = (QK_NOPE + QK_ROPE) ** -0.5
    nb = S // Q_BLOCK

    def to_blocks(t):
        return jnp.swapaxes(t.reshape((B, nb, Q_BLOCK) + t.shape[2:]), 0, 1)

    def attend(blk):
        qn, qr = blk
        s = (jnp.einsum('bqhd,bkhd->bhqk', qn, k_nope)
             + jnp.einsum('bqhd,bkd->bhqk', qr, k_rope))
        p = jax.nn.softmax(s.astype(jnp.float32) * scale, axis=-1).astype(v.dtype)
        return jnp.einsum('bhqk,bkhd->bqhd', p, v)

    o = lax.map(attend, (to_blocks(q_nope), to_blocks(q_rope)))
    return jnp.swapaxes(o, 0, 1).reshape(B, S, MLA_HEADS * V_HEAD)


def spatial_gating(z, ln_g, ln_b, w_s, b_s):
    B, S, _ = z.shape
    z = jax.nn.gelu(z)
    u, v = z[..., :SG_DIM], z[..., SG_DIM:]
    v = layernorm(v, ln_g, ln_b)
    v = v.reshape(B, S // SG_CHUNK, SG_CHUNK, SG_GROUPS, SG_DIM // SG_GROUPS)
    mixed = jnp.einsum('gts,bcsgd->bctgd', w_s, v) + b_s.T[:, :, None]
    return u * mixed.reshape(B, S, SG_DIM)


def centred_delta(z):
    prev = jnp.pad(z[:, :-1], ((0, 0), (1, 0), (0, 0)))
    nxt = jnp.pad(z[:, 1:], ((0, 0), (0, 1), (0, 0)))
    return 0.5 * (prev + nxt) - z


def rwkv7_bidir(z, mu, w0, w2, a0, a2, g2, k_k, k_a, r_k, ln_g, ln_b):
    B, S, _ = z.shape
    f32 = jnp.float32
    z = z + mu * centred_delta(z)
    cuts = np.cumsum([RWKV_DIM, RWKV_DIM, RWKV_DIM, N_DIR * DECAY_LORA, N_DIR * AAA_LORA]).tolist()
    r, k, v, wl, al, gl = jnp.split(z, cuts, axis=-1)
    wl = wl.reshape(B, S, N_DIR, DECAY_LORA)
    al = al.reshape(B, S, N_DIR, AAA_LORA)
    w = (w0 + jnp.einsum('bsnl,nlc->bsnc', jnp.tanh(wl), w2)).astype(f32)
    decay = jnp.exp(-jnp.exp(-jax.nn.softplus(-w) - 0.5))
    a = jax.nn.sigmoid((a0 + jnp.einsum('bsnl,nlc->bsnc', al, a2)).astype(f32))
    g = jax.nn.sigmoid(gl) @ g2

    def heads(t):
        return t.reshape(t.shape[:-1] + (RWKV_HEADS, RWKV_HEAD))

    kk = heads((k * k_k).astype(f32))
    kk = kk / jnp.maximum(jnp.sqrt(jnp.sum(kk * kk, axis=-1, keepdims=True)), 1e-12)
    rf, vf = heads(r.astype(f32)), heads(v.astype(f32))
    k_dir = heads(k.astype(f32)[:, :, None] * (1.0 + (a - 1.0) * k_a.astype(f32)))
    b_dir = kk[:, :, None] * heads(a)
    decay_h = heads(decay)

    def bcast(t):
        return jnp.broadcast_to(t[:, :, None], (B, S, N_DIR) + t.shape[2:])

    def time_major(t):
        t = jnp.stack([t[:, :, 0], jnp.flip(t[:, :, 1], axis=1)], axis=0)
        return jnp.transpose(t, (2, 0, 1, 3, 4))

    xs = (time_major(bcast(rf)), time_major(decay_h), time_major(k_dir),
          time_major(bcast(vf)), time_major(bcast(kk)), time_major(b_dir))

    def step(st, inp):
        r_t, w_t, k_t, v_t, kk_t, b_t = inp
        sa = jnp.einsum('dbhij,dbhj->dbhi', st, kk_t)
        st = (st * w_t[..., None, :] - sa[..., :, None] * b_t[..., None, :]
              + v_t[..., :, None] * k_t[..., None, :])
        return st, jnp.einsum('dbhij,dbhj->dbhi', st, r_t)

    s0 = jnp.zeros((N_DIR, B, RWKV_HEADS, RWKV_HEAD, RWKV_HEAD), f32)
    _, ys = lax.scan(step, s0, xs)
    y = jnp.transpose(ys[:, 0] + jnp.flip(ys[:, 1], axis=0), (1, 0, 2, 3))
    mean = jnp.mean(y, axis=-1, keepdims=True)
    var = jnp.mean(jnp.square(y - mean), axis=-1, keepdims=True)
    y = ((y - mean) * lax.rsqrt(var + GN_EPS)).reshape(B, S, RWKV_DIM)
    y = y * ln_g.astype(f32) + ln_b.astype(f32)
    bonus = jnp.sum(jnp.sum(rf[:, :, None] * k_dir * r_k.astype(f32), axis=-1, keepdims=True), axis=2)
    y = y + (bonus * vf).reshape(B, S, RWKV_DIM)
    return y.astype(z.dtype) * g


def swiglu(h, w_gate, w_up, w_down):
    return (jax.nn.silu(h @ w_gate) * (h @ w_up)) @ w_down


def setup_inputs(seed: int = 0) -> dict:
    key = jax.random.key(seed)
    ks = iter(jax.random.split(key, 40))
    nrm = lambda shape, s: jax.random.normal(next(ks), shape, jnp.float32) * s
    gain = lambda shape: 1.0 + nrm(shape, 0.02)
    L, D = DEPTH, D_MODEL
    x = jax.random.normal(next(ks), (BATCH, SEQ, D), jnp.float32)
    positions = jnp.broadcast_to(jnp.arange(SEQ, dtype=jnp.int32), (BATCH, SEQ))
    return {
        "x": x,
        "positions": positions,
        "attn_norm_g": gain((L, D)),
        "w_in": nrm((L, D, N_IN), D ** -0.5),
        "gate_b": nrm((L, N_BRANCH, D), 0.02),
        "q_norm_g": gain((L, Q_LORA)),
        "w_uq": nrm((L, Q_LORA, MLA_HEADS * (QK_NOPE + QK_ROPE)), Q_LORA ** -0.5),
        "kv_norm_g": gain((L, KV_LORA)),
        "w_ukv": nrm((L, KV_LORA, MLA_HEADS * (QK_NOPE + V_HEAD)), KV_LORA ** -0.5),
        "sg_ln_g": gain((L, SG_DIM)),
        "sg_ln_b": nrm((L, SG_DIM), 0.02),
        "sg_w": nrm((L, SG_GROUPS, SG_CHUNK, SG_CHUNK), SG_CHUNK ** -0.5),
        "sg_b": gain((L, SG_GROUPS, SG_CHUNK)),
        "rw_mu": jax.random.uniform(next(ks), (L, RWKV_IN), jnp.float32),
        "rw_w0": jax.random.uniform(next(ks), (L, N_DIR, RWKV_DIM), jnp.float32, -4.0, 1.0),
        "rw_w2": nrm((L, N_DIR, DECAY_LORA, RWKV_DIM), 0.5 * DECAY_LORA ** -0.5),
        "rw_a0": nrm((L, N_DIR, RWKV_DIM), 0.1),
        "rw_a2": nrm((L, N_DIR, AAA_LORA, RWKV_DIM), 0.5 * AAA_LORA ** -0.5),
        "rw_g2": nrm((L, GATE_LORA, RWKV_DIM), GATE_LORA ** -0.5),
        "rw_k_k": 0.85 + nrm((L, RWKV_DIM), 0.02),
        "rw_k_a": gain((L, RWKV_DIM)),
        "rw_r_k": nrm((L, RWKV_HEADS, RWKV_HEAD), 0.1),
        "rw_ln_g": gain((L, RWKV_DIM)),
        "rw_ln_b": nrm((L, RWKV_DIM), 0.02),
        "w_branch": nrm((L, N_BRANCH, BRANCH_DIM, D), BRANCH_DIM ** -0.5),
        "w_out": nrm((L, D, D), D ** -0.5),
        "ffn_norm_g": gain((L, D)),
        "w_ffn_gate": nrm((L, D, D_FF), D ** -0.5),
        "w_ffn_up": nrm((L, D, D_FF), D ** -0.5),
        "w_ffn_down": nrm((L, D_FF, D), D_FF ** -0.5),
        "final_norm_g": gain((D,)),
    }


def reference(x, positions, attn_norm_g, w_in, gate_b, q_norm_g, w_uq, kv_norm_g, w_ukv,
              sg_ln_g, sg_ln_b, sg_w, sg_b, rw_mu, rw_w0, rw_w2, rw_a0, rw_a2, rw_g2,
              rw_k_k, rw_k_a, rw_r_k, rw_ln_g, rw_ln_b, w_branch, w_out, ffn_norm_g,
              w_ffn_gate, w_ffn_up, w_ffn_down, final_norm_g):
    B, S, D = x.shape
    cuts = np.cumsum([Q_LORA, KV_LORA + QK_ROPE, SG_IN, RWKV_IN]).tolist()
    for l in range(DEPTH):
        h = rmsnorm(x, attn_norm_g[l])
        p = h @ w_in[l]
        p_q, p_kv, p_sg, p_rw, p_gate = jnp.split(p, cuts, axis=-1)
        y_a = mla_attention(p_q, p_kv, positions, q_norm_g[l], w_uq[l], kv_norm_g[l], w_ukv[l])
        y_b = spatial_gating(p_sg, sg_ln_g[l], sg_ln_b[l], sg_w[l], sg_b[l])
        y_c = rwkv7_bidir(p_rw, rw_mu[l], rw_w0[l], rw_w2[l], rw_a0[l], rw_a2[l], rw_g2[l],
                          rw_k_k[l], rw_k_a[l], rw_r_k[l], rw_ln_g[l], rw_ln_b[l])
        branches = jnp.stack([y_a, y_b, y_c], axis=2)
        gates = jax.nn.sigmoid(p_gate.reshape(B, S, N_BRANCH, D) + gate_b[l])
        merged = jnp.sum(gates * jnp.einsum('bsnc,ncd->bsnd', branches, w_branch[l]), axis=2)
        x = x + merged @ w_out[l]
        x = x + swiglu(rmsnorm(x, ffn_norm_g[l]), w_ffn_gate[l], w_ffn_up[l], w_ffn_down[l])
    return rmsnorm(x, final_norm_g)
```

```cpp
#include <hip/hip_runtime.h>
#include <hip/hip_cooperative_groups.h>
#include <cstdio>
namespace cg = cooperative_groups;

#define LAS __attribute__((address_space(3)))
typedef unsigned short bf16_t;
typedef short bf16x8 __attribute__((ext_vector_type(8)));
typedef float f32x4 __attribute__((ext_vector_type(4)));
typedef float f32x2 __attribute__((ext_vector_type(2)));
typedef unsigned u32x4 __attribute__((ext_vector_type(4)));
typedef unsigned u32x2 __attribute__((ext_vector_type(2)));

#ifndef REPEAT_MASK
#define REPEAT_MASK 0
#endif
#ifndef ONE_LAUNCH
#define ONE_LAUNCH 1
#endif

constexpr int DM = 1024, NB = 32, SEQ = 2048, NL = 2;
constexpr int TT = NB * SEQ;
constexpr int NGRP = 2;
constexpr int TG = TT / NGRP;
constexpr int GBATCH = NB / NGRP;
constexpr int NIN = 6688, NP = 3584, NPP = 3584;
constexpr int OFF_SG = 640, OFF_RW = 1664;
constexpr int DFF = 2816;
constexpr int LDS_MAIN = 136 * 1024;
constexpr int LDS_BYTES = LDS_MAIN + 16;
constexpr int XCD_BAR_WORDS_C = 3456;
constexpr int NTHREADS = 512;

constexpr size_t al256(size_t x) { return (x + 255) & ~(size_t)255; }
constexpr size_t SZ_WIN = (size_t)NPP * 1024 * 2, SZ_WG = (size_t)3072 * 1024 * 2, SZ_WUQ = (size_t)768 * 384 * 2, SZ_WUKV = (size_t)1024 * 256 * 2,
                 SZ_WLORA = (size_t)2560 * 384 * 2, SZ_WBR = (size_t)3 * 1024 * 512 * 2, SZ_WOUT = (size_t)1024 * 1024 * 2,
                 SZ_WGU = (size_t)5632 * 1024 * 2, SZ_WDN = (size_t)1024 * 2816 * 2, SZ_WSG = (size_t)8 * 128 * 128 * 2;
constexpr size_t WS_WIN = 0;
constexpr size_t WS_WG = WS_WIN + NL * SZ_WIN;
constexpr size_t WS_WUQ = WS_WG + NL * SZ_WG;
constexpr size_t WS_WUKV = WS_WUQ + NL * SZ_WUQ;
constexpr size_t WS_WLORA = WS_WUKV + NL * SZ_WUKV;
constexpr size_t WS_WBR = WS_WLORA + NL * SZ_WLORA;
constexpr size_t WS_WOUT = WS_WBR + NL * SZ_WBR;
constexpr size_t WS_WGU = WS_WOUT + NL * SZ_WOUT;
constexpr size_t WS_WDN = WS_WGU + NL * SZ_WGU;
constexpr size_t WS_WSG = WS_WDN + NL * SZ_WDN;
constexpr size_t SZ_WKR = (size_t)256 * 1024 * 2;
constexpr size_t WS_WKR = al256(WS_WSG + NL * SZ_WSG);
constexpr size_t WS_H = al256(WS_WKR + NL * SZ_WKR);
constexpr size_t WS_P = WS_H + (size_t)TG * 1024 * 2;
constexpr size_t WS_Q = WS_P + (size_t)TG * NP * 2;
constexpr size_t WS_KV = WS_Q + (size_t)TG * 768 * 2;
constexpr size_t WS_KR = WS_KV + (size_t)TG * 1024 * 2;
constexpr size_t WS_CS = WS_KR + (size_t)TG * 32 * 2;
constexpr size_t WS_YA = WS_CS + (size_t)TG * 32 * 4;
constexpr size_t WS_YB = WS_YA + (size_t)TG * 512 * 2;
constexpr size_t WS_YC = WS_YB + (size_t)TG * 512 * 2;
constexpr size_t WS_LIN = WS_YC + (size_t)TG * 512 * 2;
constexpr size_t WS_RKV = WS_LIN + (size_t)TG * 384 * 2;
constexpr size_t WS_KN = WS_RKV + (size_t)TG * 1536 * 2;
constexpr size_t WS_LOUT = WS_KN + (size_t)TG * 8 * 4;
constexpr size_t WS_YD = WS_LOUT + (size_t)TG * 2560 * 2;
constexpr size_t WS_CQN = WS_YD;
constexpr size_t WS_CKVN = WS_YD + (size_t)TG * 384 * 2;
constexpr size_t WS_XB = al256(WS_YD + (size_t)2 * TG * 512 * 2);
constexpr size_t WS_END = WS_XB + (size_t)TG * 1024 * 2;
constexpr size_t WS_BAR = al256(WS_END);
constexpr size_t WS_END2 = WS_BAR + XCD_BAR_WORDS_C * 4;
static_assert(WS_END2 <= ((size_t)1 << 30), "workspace map exceeds 1 GiB");

struct Ctx { int tid, bx, gd; };
__device__ __forceinline__ float bf2f(unsigned b) { return __uint_as_float(b << 16); }
__device__ __forceinline__ float bflo(unsigned w) { return __uint_as_float(w << 16); }
__device__ __forceinline__ float bfhi(unsigned w) { return __uint_as_float(w & 0xffff0000u); }
typedef __bf16 bf16x2_t __attribute__((ext_vector_type(2)));
__device__ __forceinline__ unsigned pk2(float lo, float hi) { const f32x2 v = {lo, hi}; const bf16x2_t b = __builtin_convertvector(v, bf16x2_t); return __builtin_bit_cast(unsigned, b); }
__device__ __forceinline__ unsigned f2bf(float f) { return pk2(f, 0.0f); }
__device__ __forceinline__ float sigmoidf_(float x) { return __builtin_amdgcn_rcpf(1.0f + __expf(-x)); }
__device__ __forceinline__ float tanhf_(float y) { return 1.0f - 2.0f * __builtin_amdgcn_rcpf(__expf(2.0f * y) + 1.0f); }
__device__ __forceinline__ float gelu_tanh(float x) { return 0.5f * x * (1.0f + tanhf_(0.7978845608028654f * (x + 0.044715f * x * x * x))); }
__device__ __forceinline__ void lds_barrier() { asm volatile("s_waitcnt lgkmcnt(0)" ::: "memory"); __builtin_amdgcn_s_barrier(); asm volatile("" ::: "memory"); }
template <int CTRL> __device__ __forceinline__ float dppf(float v) { return __int_as_float(__builtin_amdgcn_update_dpp(0, __float_as_int(v), CTRL, 0xF, 0xF, true)); }
__device__ __forceinline__ float red16(float v) {
    v += dppf<0xB1>(v);
    v += dppf<0x4E>(v);
    v += dppf<0x141>(v);
    v += dppf<0x140>(v);
    return v;
}


__device__ __forceinline__ float sum_swap16(float v) { const auto r = __builtin_amdgcn_permlane16_swap(__float_as_uint(v), __float_as_uint(v), false, false); return __uint_as_float(r[0]) + __uint_as_float(r[1]); }
__device__ __forceinline__ float sum_swap32(float v) { const auto r = __builtin_amdgcn_permlane32_swap(__float_as_uint(v), __float_as_uint(v), false, false); return __uint_as_float(r[0]) + __uint_as_float(r[1]); }
__device__ __forceinline__ float max_swap16(float v) { const auto r = __builtin_amdgcn_permlane16_swap(__float_as_uint(v), __float_as_uint(v), false, false); return fmaxf(__uint_as_float(r[0]), __uint_as_float(r[1])); }
__device__ __forceinline__ float max_swap32(float v) { const auto r = __builtin_amdgcn_permlane32_swap(__float_as_uint(v), __float_as_uint(v), false, false); return fmaxf(__uint_as_float(r[0]), __uint_as_float(r[1])); }
__device__ __forceinline__ float wsum(float v) { return sum_swap32(sum_swap16(red16(v))); }
__device__ __forceinline__ float hsum32(float v) { return sum_swap16(red16(v)); }
__device__ __forceinline__ float red8(float v) { v += dppf<0xB1>(v); v += dppf<0x4E>(v); v += dppf<0x141>(v); return v; }

#define XB_TMO      128
#define XB_XCNT(j)  (256  + 64 * (j))
#define XB_XSUB(j)  (1280 + 64 * (j))
#define XB_XGEN(j)  (2304 + 64 * (j))
#define XB_TOP      3328
#define XB_TOPGEN   3392
#define XCD_BAR_WORDS 3456
#define XB_SPIN_CAP (1u << 22)
__device__ __forceinline__ unsigned xb_ld(unsigned* p)              { return __hip_atomic_load(p, __ATOMIC_RELAXED, __HIP_MEMORY_SCOPE_AGENT); }
__device__ __forceinline__ unsigned xb_add(unsigned* p, unsigned v) { return __hip_atomic_fetch_add(p, v, __ATOMIC_RELAXED, __HIP_MEMORY_SCOPE_AGENT); }
__device__ __forceinline__ unsigned xb_xcc_id() { return (unsigned)__builtin_amdgcn_s_getreg((3 << 11) | 20) & 0xFu; }
#define XB_SPIN(cond, bar) do { unsigned _sp = 0; while (cond) { __builtin_amdgcn_s_sleep(1); \
    if ((++_sp & 255u) == 0u) { if (xb_ld(&(bar)[XB_TMO])) break; if (_sp > XB_SPIN_CAP) { atomicAdd(&(bar)[XB_TMO], 1u); break; } } } } while (0)
struct XcdBarrier { unsigned* bar; unsigned x; volatile LAS unsigned* st; };
__device__ __forceinline__ void xcd_barrier_complete(unsigned* bar, unsigned x, unsigned G, unsigned& nloc, unsigned& nx) {
    unsigned sum, cnt, mine, sp = 0u;
    for (;;) {
        sum = 0u; cnt = 0u; mine = 0u;
#pragma unroll
        for (unsigned j = 0; j < 16; ++j) { const unsigned c = xb_ld(&bar[XB_XCNT(j)]); sum += c; cnt += (c > 0u) ? 1u : 0u; mine = (j == x) ? c : mine; }
        if (sum == G) break;
        __builtin_amdgcn_s_sleep(1);
        if ((++sp & 255u) == 0u) { if (xb_ld(&bar[XB_TMO])) break; if (sp > XB_SPIN_CAP) { atomicAdd(&bar[XB_TMO], 1u); break; } }
    }
    nloc = mine > 0u ? mine : 1u; nx = cnt > 0u ? cnt : 1u;
}
__device__ __forceinline__ void xcd_barrier(const XcdBarrier& b, int tid, unsigned G) {
    asm volatile("s_waitcnt vmcnt(0)" ::: "memory");
    __syncthreads();
    if (tid == 0) {
        unsigned* bar = b.bar;
        __builtin_amdgcn_s_waitcnt(0);
        unsigned nloc = b.st[0], nx = b.st[1];
        if (nloc == 0u) { xcd_barrier_complete(bar, b.x, G, nloc, nx); b.st[0] = nloc; b.st[1] = nx; }
        const unsigned old = xb_add(&bar[XB_XSUB(b.x)], 1u);
        const unsigned gen = old / nloc;
        if (old + 1u == (gen + 1u) * nloc) {
            __builtin_amdgcn_fence(__ATOMIC_RELEASE, "agent");
            asm volatile("s_waitcnt vmcnt(0)" ::: "memory");
            const unsigned og = xb_add(&bar[XB_TOP], 1u);
            const unsigned tg = og / nx;
            if (og + 1u == (tg + 1u) * nx) xb_add(&bar[XB_TOPGEN], 1u);
            else XB_SPIN(xb_ld(&bar[XB_TOPGEN]) == tg, bar);
            __builtin_amdgcn_fence(__ATOMIC_ACQUIRE, "agent");
            xb_add(&bar[XB_XGEN(b.x)], 1u);
            asm volatile("s_waitcnt vmcnt(0)" ::: "memory");
        } else {
            XB_SPIN(xb_ld(&bar[XB_XGEN(b.x)]) == gen, bar);
            __builtin_amdgcn_fence(__ATOMIC_ACQUIRE, "agent");
            asm volatile("s_waitcnt vmcnt(0)" ::: "memory");
        }
    }
    __syncthreads();
}

namespace pg8 {
constexpr int BM = 256, BK = 64, HALF = 128, HTB = HALF * BK * 2, STAGE_BYTES = 8 * HTB, NXCD = 8, WGM = 8;
__host__ __device__ __forceinline__ int lds_byte(int r, int c) { const int st = (r >> 4) * 2 + (c >> 5), rr = r & 15, cc = c & 31, ob = rr * 64 + cc * 2; return st * 1024 + (ob ^ (((ob >> 9) & 1) << 5)); }
__host__ __device__ __forceinline__ void stage_rc(int b, int& R, int& C) { const int st = b / 1024, sb = b % 1024, swz = sb ^ (((sb >> 9) & 1) << 5); R = (st >> 1) * 16 + swz / 64; C = (st & 1) * 32 + (swz % 64) / 2; }
__host__ __device__ __forceinline__ int perm32(int rho) { const int n = rho >> 4, i = rho & 15; return 8 * (i >> 2) + 4 * n + (i & 3); }
struct Unit { int pm, pn; };
struct Gemm { const bf16_t* A; const bf16_t* Bt; int M, N, K, lda; };
struct StaticOrder {
    int nM, nN, nwg, G, c;
    __device__ void init(int M, int N, int G_, int c_) { nM = M / BM; nN = N / BM; nwg = nM * nN; G = G_; c = c_; }
    __device__ bool next(int i, Unit& u) const {
        const long L = (long)i * G + c; if (L >= nwg) return false;
        int wgid = (int)L; { const int q = nwg / NXCD, r = nwg % NXCD, xcd = wgid % NXCD, off = wgid / NXCD; wgid = (xcd < r ? xcd * (q + 1) : r * (q + 1) + (xcd - r) * q) + off; }
        const int nig = WGM * nN, gid = wgid / nig, fm = gid * WGM, gsz = (nM - fm) < WGM ? (nM - fm) : WGM;
        u.pm = fm + ((wgid % nig) % gsz); u.pn = (wgid % nig) / gsz; return true;
    }
};
__device__ __forceinline__ unsigned cvt_pk_bf16(float lo, float hi) { return pk2(lo, hi); }

template <class Epi>
__device__ __forceinline__ void gemm_phase(const Ctx cx, LAS unsigned char* lds, const Gemm g, const StaticOrder& S, const Epi& E) {
    const int tid = cx.tid, wid = __builtin_amdgcn_readfirstlane(tid >> 6), lane = tid & 63, wr = wid >> 2, wc = wid & 3, fr = lane & 15, fq = lane >> 4;
    int K = g.K, lda = g.lda; asm volatile("" : "+s"(K), "+s"(lda));
    const int nt = K / BK;
    unsigned voffA[2], voffB[2];
#pragma unroll
    for (int i = 0; i < 2; ++i) { int R, C; stage_rc(tid * 16 + i * 8192, R, C); const int Rb = Epi::PERM ? ((R & ~31) + perm32(R & 31)) : R;
        voffA[i] = (unsigned)(R * lda + C) * 2u; voffB[i] = (unsigned)(Rb * K + C) * 2u; }
    const size_t kstep = (size_t)(BK * 2);
    const size_t hstepA = (size_t)HALF * lda * 2, hstepB = (size_t)HALF * K * 2;
    const size_t tstepA = 2 * hstepA, tstepB = 2 * hstepB;
    const unsigned ldsw = (unsigned)wid * 1024u;
    const int aoff = lds_byte(wr * 64 + fr, fq * 8), boff = lds_byte(wc * 32 + fr, fq * 8);
#define PG8_SA(b, h) (((b) * 2 + (h)) * HTB)
#define PG8_SB(b, h) ((4 + (b) * 2 + (h)) * HTB)
#define PG8_STAGE(bufoff, gbase, voff) do { _Pragma("unroll") for (int _i = 0; _i < 2; ++_i) \
        __builtin_amdgcn_global_load_lds((const unsigned*)((const char*)(gbase) + (voff)[_i]), (LAS unsigned*)(lds + (bufoff) + ldsw + _i * 8192), 16, 0, 0); } while (0)
#define PG8_LDA(dst, b, h) do { _Pragma("unroll") for (int m = 0; m < 4; ++m) _Pragma("unroll") for (int k = 0; k < 2; ++k) dst[m][k] = *(const LAS bf16x8*)(lds + PG8_SA(b, h) + aoff + m * 2048 + k * 1024); } while (0)
#define PG8_LDB(dst, b, h) do { _Pragma("unroll") for (int n = 0; n < 2; ++n) _Pragma("unroll") for (int k = 0; k < 2; ++k) dst[n][k] = *(const LAS bf16x8*)(lds + PG8_SB(b, h) + boff + n * 2048 + k * 1024); } while (0)
#define PG8_MMA(ai, bj, At, Bt) do { __builtin_amdgcn_s_setprio(1); _Pragma("unroll") for (int m = 0; m < 4; ++m) _Pragma("unroll") for (int n = 0; n < 2; ++n) _Pragma("unroll") for (int k = 0; k < 2; ++k) \
        acc[ai][bj][m][n] = __builtin_amdgcn_mfma_f32_16x16x32_bf16(Bt[n][k], At[m][k], acc[ai][bj][m][n], 0, 0, 0); __builtin_amdgcn_s_setprio(0); } while (0)
#define PG8_WAIT_V(n) asm volatile("s_waitcnt vmcnt(" #n ")" ::: "memory")
#define PG8_WAIT_L(n) asm volatile("s_waitcnt lgkmcnt(" #n ")" ::: "memory")
#define PG8_BAR __builtin_amdgcn_s_barrier()
#define PG8_SCHED __builtin_amdgcn_sched_barrier(0)
    Unit cur, nxt; int ui = 0;
    if (!S.next(0, cur)) return;
    f32x4 acc[2][2][4][2];
#pragma unroll
    for (int a = 0; a < 2; ++a)
#pragma unroll
        for (int b = 0; b < 2; ++b)
#pragma unroll
            for (int m = 0; m < 4; ++m)
#pragma unroll
                for (int n = 0; n < 2; ++n) acc[a][b][m][n] = (f32x4){0.f, 0.f, 0.f, 0.f};
    bf16x8 At[4][2], B0[2][2], B1[2][2];
    const char* cA = (const char*)g.A + (size_t)cur.pm * tstepA; const char* cB = (const char*)g.Bt + (size_t)cur.pn * tstepB;
    PG8_STAGE(PG8_SB(0, 0), cB, voffB); PG8_STAGE(PG8_SA(0, 0), cA, voffA); PG8_STAGE(PG8_SB(0, 1), cB + hstepB, voffB); PG8_STAGE(PG8_SA(0, 1), cA + hstepA, voffA);
    if (wr == 1) PG8_BAR;
    PG8_WAIT_V(4); PG8_BAR;
    PG8_STAGE(PG8_SB(1, 0), cB + kstep, voffB); PG8_STAGE(PG8_SA(1, 0), cA + kstep, voffA); PG8_STAGE(PG8_SB(1, 1), cB + hstepB + kstep, voffB);
    PG8_WAIT_V(6); PG8_BAR;
    for (;;) {
        const bool has_next = S.next(ui + 1, nxt);
        const char* nA = has_next ? (const char*)g.A + (size_t)nxt.pm * tstepA : cA; const char* nB = has_next ? (const char*)g.Bt + (size_t)nxt.pn * tstepB : cB;
#pragma unroll 1
        for (int t = 0; t < nt; t += 2) {
            const bool last = (t == nt - 2);
            const char* a1 = cA + (size_t)(t + 1) * kstep;
            const char* a2 = last ? nA : cA + (size_t)(t + 2) * kstep; const char* b2 = last ? nB : cB + (size_t)(t + 2) * kstep;
            const char* a3 = a2 + kstep; const char* b3 = b2 + kstep;
            PG8_LDB(B0, 0, 0); PG8_SCHED; PG8_LDA(At, 0, 0); PG8_STAGE(PG8_SA(1, 1), a1 + hstepA, voffA);
            PG8_WAIT_L(8); PG8_BAR; PG8_WAIT_L(0); PG8_MMA(0, 0, At, B0); PG8_BAR; PG8_SCHED;
            PG8_LDB(B1, 0, 1); PG8_STAGE(PG8_SB(0, 0), b2, voffB);
            PG8_BAR; PG8_WAIT_L(0); PG8_MMA(0, 1, At, B1); PG8_BAR;
            PG8_LDA(At, 0, 1); PG8_STAGE(PG8_SA(0, 0), a2, voffA);
            PG8_BAR; PG8_WAIT_L(0); PG8_MMA(1, 0, At, B0); PG8_BAR; PG8_SCHED;
            PG8_STAGE(PG8_SB(0, 1), b2 + hstepB, voffB);
            PG8_WAIT_V(6); PG8_BAR; PG8_MMA(1, 1, At, B1); PG8_BAR;
            PG8_LDB(B0, 1, 0); PG8_SCHED; PG8_LDA(At, 1, 0); PG8_STAGE(PG8_SA(0, 1), a2 + hstepA, voffA);
            PG8_WAIT_L(8); PG8_BAR; PG8_WAIT_L(0); PG8_MMA(0, 0, At, B0); PG8_BAR; PG8_SCHED;
            PG8_LDB(B1, 1, 1); PG8_STAGE(PG8_SB(1, 0), b3, voffB);
            PG8_BAR; PG8_WAIT_L(0); PG8_MMA(0, 1, At, B1); PG8_BAR;
            PG8_LDA(At, 1, 1); PG8_STAGE(PG8_SA(1, 0), a3, voffA);
            PG8_BAR; PG8_WAIT_L(0); PG8_MMA(1, 0, At, B0); PG8_BAR; PG8_SCHED;
            PG8_STAGE(PG8_SB(1, 1), b3 + hstepB, voffB);
            PG8_WAIT_V(6); PG8_BAR; PG8_MMA(1, 1, At, B1); PG8_BAR;
        }
        E(acc, cur, wr, wc, fr, fq);
        if (!has_next) break;
#pragma unroll
        for (int a = 0; a < 2; ++a)
#pragma unroll
            for (int b = 0; b < 2; ++b)
#pragma unroll
                for (int m = 0; m < 4; ++m)
#pragma unroll
                    for (int n = 0; n < 2; ++n) acc[a][b][m][n] = (f32x4){0.f, 0.f, 0.f, 0.f};
        cur = nxt; cA = nA; cB = nB; ++ui;
    }
    PG8_WAIT_V(0);
    if (wr == 0) PG8_BAR;
    PG8_BAR;
#undef PG8_SA
#undef PG8_SB
#undef PG8_STAGE
#undef PG8_LDA
#undef PG8_LDB
#undef PG8_MMA
#undef PG8_WAIT_V
#undef PG8_WAIT_L
#undef PG8_BAR
#undef PG8_SCHED
}

#define EPI_ARGS const f32x4 (&acc)[2][2][4][2], const Unit& u, int wr, int wc, int fr, int fq
#define FOR_AIM _Pragma("unroll") for (int ai = 0; ai < 2; ++ai) _Pragma("unroll") for (int m = 0; m < 4; ++m)

struct EpiStore {
    static constexpr bool PERM = true;
    bf16_t* O; int ldc; int ncols;
    __device__ __forceinline__ void operator()(EPI_ARGS) const {
        const int row0 = u.pm * BM + wr * 64 + fr, col0 = u.pn * BM + wc * 32 + 8 * fq;
        FOR_AIM { const int row = row0 + ai * HALF + m * 16;
#pragma unroll
            for (int bj = 0; bj < 2; ++bj) { const int col = col0 + bj * HALF; if (col < ncols) {
                const f32x4 v0 = acc[ai][bj][m][0], v1 = acc[ai][bj][m][1];
                u32x4 o; o[0] = cvt_pk_bf16(v0[0], v0[1]); o[1] = cvt_pk_bf16(v0[2], v0[3]); o[2] = cvt_pk_bf16(v1[0], v1[1]); o[3] = cvt_pk_bf16(v1[2], v1[3]);
                *(u32x4*)(O + (size_t)row * ldc + col) = o; } } }
    }
};
struct EpiQ {
    static constexpr bool PERM = false;
    bf16_t* O; const float* cs;
    __device__ __forceinline__ void operator()(EPI_ARGS) const {
        const float QS = 0.10206207261596575f * 1.4426950408889634f;
        const int row0 = u.pm * BM + wr * 64 + fr;
#pragma unroll
        for (int bj = 0; bj < 2; ++bj) { const int cb = u.pn * BM + bj * HALF + wc * 32; const bool rope = (cb % 96) == 64;
            FOR_AIM { const int row = row0 + ai * HALF + m * 16;
                f32x4 v0 = acc[ai][bj][m][0] * QS, v1 = acc[ai][bj][m][1] * QS;
                if (rope) { const f32x4 c4 = *(const f32x4*)(cs + (size_t)row * 32 + 4 * fq), s4 = *(const f32x4*)(cs + (size_t)row * 32 + 16 + 4 * fq);
                    const f32x4 o0 = v0 * c4 - v1 * s4, o1 = v0 * s4 + v1 * c4; v0 = o0; v1 = o1; }
                u32x2 a, b; a[0] = cvt_pk_bf16(v0[0], v0[1]); a[1] = cvt_pk_bf16(v0[2], v0[3]); b[0] = cvt_pk_bf16(v1[0], v1[1]); b[1] = cvt_pk_bf16(v1[2], v1[3]);
                *(u32x2*)(O + (size_t)row * 768 + cb + 4 * fq) = a; *(u32x2*)(O + (size_t)row * 768 + cb + 16 + 4 * fq) = b; } }
    }
};
struct EpiKR {
    static constexpr bool PERM = false;
    bf16_t* O; const float* cs;
    __device__ __forceinline__ void operator()(EPI_ARGS) const {
        if (u.pn != 0 || wc != 0) return;
        const int row0 = u.pm * BM + wr * 64 + fr;
        FOR_AIM { const int row = row0 + ai * HALF + m * 16;
            const f32x4 v0 = acc[ai][0][m][0], v1 = acc[ai][0][m][1];
            const f32x4 c4 = *(const f32x4*)(cs + (size_t)row * 32 + 4 * fq), s4 = *(const f32x4*)(cs + (size_t)row * 32 + 16 + 4 * fq);
            const f32x4 o0 = v0 * c4 - v1 * s4, o1 = v0 * s4 + v1 * c4;
            u32x2 a, b; a[0] = cvt_pk_bf16(o0[0], o0[1]); a[1] = cvt_pk_bf16(o0[2], o0[3]); b[0] = cvt_pk_bf16(o1[0], o1[1]); b[1] = cvt_pk_bf16(o1[2], o1[3]);
            *(u32x2*)(O + (size_t)row * 32 + 4 * fq) = a; *(u32x2*)(O + (size_t)row * 32 + 16 + 4 * fq) = b; }
    }
};
struct EpiLora {
    static constexpr bool PERM = true;
    bf16_t* O; const float* w0; const float* a0; int cbase;
    __device__ __forceinline__ void operator()(EPI_ARGS) const {
        const int row0 = u.pm * BM + wr * 64 + fr, col0 = cbase + u.pn * BM + wc * 32 + 8 * fq;
        const int tcol = cbase + u.pn * BM; const int kind = tcol < 1024 ? 0 : (tcol < 2048 ? 1 : 2);
#pragma unroll
        for (int bj = 0; bj < 2; ++bj) { const int col = col0 + bj * HALF;
            f32x4 b0 = (f32x4){0.f, 0.f, 0.f, 0.f}, b1 = b0;
            if (kind == 0) { b0 = *(const f32x4*)(w0 + col); b1 = *(const f32x4*)(w0 + col + 4); }
            else if (kind == 1) { b0 = *(const f32x4*)(a0 + col - 1024); b1 = *(const f32x4*)(a0 + col - 1020); }
            FOR_AIM { const int row = row0 + ai * HALF + m * 16;
                f32x4 v0 = acc[ai][bj][m][0] + b0, v1 = acc[ai][bj][m][1] + b1;
                if (kind == 0) {
#pragma unroll
                    for (int j = 0; j < 4; ++j) { v0[j] = 1.0f - __expf(-0.6065306597126334f * sigmoidf_(v0[j])); v1[j] = 1.0f - __expf(-0.6065306597126334f * sigmoidf_(v1[j])); } }
                else if (kind == 1) {
#pragma unroll
                    for (int j = 0; j < 4; ++j) { v0[j] = sigmoidf_(v0[j]); v1[j] = sigmoidf_(v1[j]); } }
                u32x4 o; o[0] = cvt_pk_bf16(v0[0], v0[1]); o[1] = cvt_pk_bf16(v0[2], v0[3]); o[2] = cvt_pk_bf16(v1[0], v1[1]); o[3] = cvt_pk_bf16(v1[2], v1[3]);
                *(u32x4*)(O + (size_t)row * 2560 + col) = o; } }
    }
};
struct EpiGate {
    static constexpr bool PERM = true;
    bf16_t* O; const float* bias;
    __device__ __forceinline__ void operator()(EPI_ARGS) const {
        const int row0 = u.pm * BM + wr * 64 + fr, col0 = u.pn * BM + wc * 32 + 8 * fq;
#pragma unroll
        for (int bj = 0; bj < 2; ++bj) { const int col = col0 + bj * HALF;
            const f32x4 b0 = *(const f32x4*)(bias + col) * -1.4426950408889634f, b1 = *(const f32x4*)(bias + col + 4) * -1.4426950408889634f;
            FOR_AIM { const int row = row0 + ai * HALF + m * 16;
                f32x4 v0, v1;
#pragma unroll
                for (int j = 0; j < 4; ++j) { v0[j] = __builtin_amdgcn_rcpf(1.0f + __builtin_amdgcn_exp2f(__builtin_fmaf(acc[ai][bj][m][0][j], -1.4426950408889634f, b0[j])));
                                              v1[j] = __builtin_amdgcn_rcpf(1.0f + __builtin_amdgcn_exp2f(__builtin_fmaf(acc[ai][bj][m][1][j], -1.4426950408889634f, b1[j]))); }
                u32x4 o; o[0] = cvt_pk_bf16(v0[0], v0[1]); o[1] = cvt_pk_bf16(v0[2], v0[3]); o[2] = cvt_pk_bf16(v1[0], v1[1]); o[3] = cvt_pk_bf16(v1[2], v1[3]);
                *(u32x4*)(O + (size_t)row * 3072 + col) = o; } }
    }
};
struct EpiBranch {
    static constexpr bool PERM = true;
    bf16_t* MG; const bf16_t* G; int nb;
    __device__ __forceinline__ void operator()(EPI_ARGS) const {
        const int row0 = u.pm * BM + wr * 64 + fr, col0 = u.pn * BM + wc * 32 + 8 * fq;
        FOR_AIM { const int row = row0 + ai * HALF + m * 16;
#pragma unroll
            for (int bj = 0; bj < 2; ++bj) { const int col = col0 + bj * HALF;
                const u32x4 gq = *(const u32x4*)(G + (size_t)row * 3072 + nb * 1024 + col);
                const f32x4 a0 = acc[ai][bj][m][0], a1 = acc[ai][bj][m][1];
                float v[8];
                v[0] = bflo(gq[0]) * a0[0]; v[1] = bfhi(gq[0]) * a0[1]; v[2] = bflo(gq[1]) * a0[2]; v[3] = bfhi(gq[1]) * a0[3];
                v[4] = bflo(gq[2]) * a1[0]; v[5] = bfhi(gq[2]) * a1[1]; v[6] = bflo(gq[3]) * a1[2]; v[7] = bfhi(gq[3]) * a1[3];
                bf16_t* dst = MG + (size_t)row * 1024 + col;
                if (nb > 0) { const u32x4 mq = *(const u32x4*)dst;
#pragma unroll
                    for (int j = 0; j < 4; ++j) { v[2 * j] += bflo(mq[j]); v[2 * j + 1] += bfhi(mq[j]); } }
                u32x4 o; o[0] = cvt_pk_bf16(v[0], v[1]); o[1] = cvt_pk_bf16(v[2], v[3]); o[2] = cvt_pk_bf16(v[4], v[5]); o[3] = cvt_pk_bf16(v[6], v[7]);
                *(u32x4*)dst = o; } }
    }
};
struct EpiResid {
    static constexpr bool PERM = false;
    const float* xin; float* xout;
    __device__ __forceinline__ void operator()(EPI_ARGS) const {
        const int row0 = u.pm * BM + wr * 64 + fr, col0 = u.pn * BM + wc * 32 + 4 * fq;
        FOR_AIM { const size_t ro = (size_t)(row0 + ai * HALF + m * 16) * 1024 + col0;
#pragma unroll
            for (int bj = 0; bj < 2; ++bj)
#pragma unroll
                for (int n = 0; n < 2; ++n) { const size_t o = ro + bj * HALF + n * 16; *(f32x4*)(xout + o) = *(const f32x4*)(xin + o) + acc[ai][bj][m][n]; } }
    }
};
template <bool IN_F32> struct EpiResidB {
    static constexpr bool PERM = true;
    const float* xin32; const bf16_t* xinb; bf16_t* xout;
    __device__ __forceinline__ void operator()(EPI_ARGS) const {
        const int row0 = u.pm * BM + wr * 64 + fr, col0 = u.pn * BM + wc * 32 + 8 * fq;
        FOR_AIM { const int row = row0 + ai * HALF + m * 16;
#pragma unroll
            for (int bj = 0; bj < 2; ++bj) { const size_t o = (size_t)row * 1024 + col0 + bj * HALF;
                const f32x4 a0 = acc[ai][bj][m][0], a1 = acc[ai][bj][m][1]; float v[8];
                if (IN_F32) { const f32x4 x0 = *(const f32x4*)(xin32 + o), x1 = *(const f32x4*)(xin32 + o + 4);
#pragma unroll
                    for (int j = 0; j < 4; ++j) { v[j] = x0[j] + a0[j]; v[4 + j] = x1[j] + a1[j]; } }
                else { const u32x4 xq = *(const u32x4*)(xinb + o);
                    v[0] = bflo(xq[0]) + a0[0]; v[1] = bfhi(xq[0]) + a0[1]; v[2] = bflo(xq[1]) + a0[2]; v[3] = bfhi(xq[1]) + a0[3];
                    v[4] = bflo(xq[2]) + a1[0]; v[5] = bfhi(xq[2]) + a1[1]; v[6] = bflo(xq[3]) + a1[2]; v[7] = bfhi(xq[3]) + a1[3]; }
                u32x4 w; w[0] = cvt_pk_bf16(v[0], v[1]); w[1] = cvt_pk_bf16(v[2], v[3]); w[2] = cvt_pk_bf16(v[4], v[5]); w[3] = cvt_pk_bf16(v[6], v[7]);
                *(u32x4*)(xout + o) = w; } }
    }
};
struct EpiGU {
    static constexpr bool PERM = true;
    bf16_t* O;
    __device__ __forceinline__ void operator()(EPI_ARGS) const {
        const int row0 = u.pm * BM + wr * 64 + fr, oc0 = u.pn * 128 + wc * 32 + 8 * fq;
        FOR_AIM { const int row = row0 + ai * HALF + m * 16; float v[8];
#pragma unroll
            for (int n = 0; n < 2; ++n) { const f32x4 gt = acc[ai][0][m][n], up = acc[ai][1][m][n];
#pragma unroll
                for (int j = 0; j < 4; ++j) v[4 * n + j] = gt[j] * sigmoidf_(gt[j]) * up[j]; }
            u32x4 o; o[0] = cvt_pk_bf16(v[0], v[1]); o[1] = cvt_pk_bf16(v[2], v[3]); o[2] = cvt_pk_bf16(v[4], v[5]); o[3] = cvt_pk_bf16(v[6], v[7]);
            *(u32x4*)(O + (size_t)row * DFF + oc0) = o; }
    }
};
}

template <class F> __device__ __forceinline__ void conv_t(const Ctx cx, float* tl, bf16_t* dst, int K, int N, F src) {
    const int tid = cx.tid; const int nk = K / 64, nn = N / 64, ntile = nk * nn;
    float rg[8];
    int t = cx.bx;
    if (t < ntile) { const int k0 = (t % nk) * 64, n0 = (t / nk) * 64;
#pragma unroll
        for (int i = 0; i < 8; ++i) rg[i] = src(k0 + (tid >> 6) + 8 * i, n0 + (tid & 63)); }
    for (; t < ntile; t += cx.gd) {
        const int k0 = (t % nk) * 64, n0 = (t / nk) * 64;
        lds_barrier();
#pragma unroll
        for (int i = 0; i < 8; ++i) tl[((tid >> 6) + 8 * i) * 65 + (tid & 63)] = rg[i];
        lds_barrier();
        const int tn = t + cx.gd;
        if (tn < ntile) { const int k1 = (tn % nk) * 64, n1 = (tn / nk) * 64;
#pragma unroll
            for (int i = 0; i < 8; ++i) rg[i] = src(k1 + (tid >> 6) + 8 * i, n1 + (tid & 63)); }
#pragma unroll
        for (int i = 0; i < 8; ++i) { const int n = (tid >> 6) + 8 * i, k = tid & 63; dst[(size_t)(n0 + n) * K + k0 + k] = (bf16_t)f2bf(tl[k * 65 + n]); }
    }
}

struct Params { const float* in[31]; float* out; unsigned char* ws; int ph_lo, ph_hi; };
typedef const __attribute__((opencl_constant)) Params* KP;
__device__ __forceinline__ KP get_kp() { auto k = __builtin_amdgcn_kernarg_segment_ptr(); asm volatile("" : "+s"(k)); return (KP)k; }

__device__ __forceinline__ void phase_convert(const Ctx cx, KP p, unsigned char* smem) {
    float* tl = (float*)smem; unsigned char* ws = p->ws;
    for (int l = 0; l < NL; ++l) {
        { const float* w = p->in[3] + (size_t)l * 1024 * NIN;
          conv_t(cx, tl, (bf16_t*)(ws + WS_WIN + l * SZ_WIN), 1024, NPP, [=](int k, int n) { return w[(size_t)k * NIN + (n < 640 ? n : n + 32)]; });
          conv_t(cx, tl, (bf16_t*)(ws + WS_WKR + l * SZ_WKR), 1024, 256, [=](int k, int n) { return n < 32 ? w[(size_t)k * NIN + 640 + n] : 0.0f; });
          conv_t(cx, tl, (bf16_t*)(ws + WS_WG + l * SZ_WG), 1024, 3072, [=](int k, int n) { return w[(size_t)k * NIN + 3616 + n]; }); }
        { const float* w = p->in[6] + (size_t)l * 384 * 768; conv_t(cx, tl, (bf16_t*)(ws + WS_WUQ + l * SZ_WUQ), 384, 768, [=](int k, int n) { return w[(size_t)k * 768 + n]; }); }
        { const float* w = p->in[8] + (size_t)l * 256 * 1024; conv_t(cx, tl, (bf16_t*)(ws + WS_WUKV + l * SZ_WUKV), 256, 1024, [=](int k, int n) { return w[(size_t)k * 1024 + n]; }); }
        { const float* w2 = p->in[15] + (size_t)l * 2 * 64 * 512; const float* a2 = p->in[17] + (size_t)l * 2 * 64 * 512; const float* g2 = p->in[18] + (size_t)l * 128 * 512;
          conv_t(cx, tl, (bf16_t*)(ws + WS_WLORA + l * SZ_WLORA), 256, 2048, [=](int k, int n) {
              const int blk = n >> 9, c = n & 511;
              if ((k >> 6) != blk) return 0.0f;
              return blk < 2 ? w2[(size_t)(blk * 64 + (k & 63)) * 512 + c] : a2[(size_t)((blk - 2) * 64 + (k & 63)) * 512 + c]; });
          conv_t(cx, tl, (bf16_t*)(ws + WS_WLORA + l * SZ_WLORA) + (size_t)2048 * 256, 256, 512, [=](int k, int n) { return k >= 128 ? g2[(size_t)(k - 128) * 512 + n] : 0.0f; }); }
        for (int nb = 0; nb < 3; ++nb) { const float* w = p->in[24] + (size_t)(l * 3 + nb) * 512 * 1024;
          conv_t(cx, tl, (bf16_t*)(ws + WS_WBR + l * SZ_WBR) + (size_t)nb * 1024 * 512, 512, 1024, [=](int k, int n) { return w[(size_t)k * 1024 + n]; }); }
        { const float* w = p->in[25] + (size_t)l * 1024 * 1024; conv_t(cx, tl, (bf16_t*)(ws + WS_WOUT + l * SZ_WOUT), 1024, 1024, [=](int k, int n) { return w[(size_t)k * 1024 + n]; }); }
        { const float* wg = p->in[27] + (size_t)l * 1024 * DFF; const float* wu = p->in[28] + (size_t)l * 1024 * DFF;
          conv_t(cx, tl, (bf16_t*)(ws + WS_WGU + l * SZ_WGU), 1024, 5632, [=](int k, int c) { const int j = (c >> 8) * 128 + (c & 127); return (c & 128) ? wu[(size_t)k * DFF + j] : wg[(size_t)k * DFF + j]; }); }
        { const float* w = p->in[29] + (size_t)l * DFF * 1024; conv_t(cx, tl, (bf16_t*)(ws + WS_WDN + l * SZ_WDN), DFF, 1024, [=](int k, int n) { return w[(size_t)k * 1024 + n]; }); }
    }
    { const float* w = p->in[11]; bf16_t* d = (bf16_t*)(ws + WS_WSG);
      for (size_t i = (size_t)cx.bx * NTHREADS + cx.tid; i < (size_t)NL * 8 * 128 * 128; i += (size_t)cx.gd * NTHREADS) d[i] = (bf16_t)f2bf(w[i]); }
}

__device__ __forceinline__ void phase_rmsnorm(const Ctx cx, const float* __restrict__ x, const float* __restrict__ g, bf16_t* __restrict__ h, int rows) {
    const int wv = cx.tid >> 6, lane = cx.tid & 63;
    constexpr int NR = 8;
    f32x4 g4[4];
#pragma unroll
    for (int i = 0; i < 4; ++i) g4[i] = *(const f32x4*)(g + i * 256 + lane * 4);
    for (int r0 = (cx.bx * 8 + wv) * NR; r0 < rows; r0 += cx.gd * 8 * NR) {
        f32x4 v[NR][4];
#pragma unroll
        for (int k = 0; k < NR; ++k)
#pragma unroll
            for (int i = 0; i < 4; ++i) v[k][i] = *(const f32x4*)(x + (size_t)(r0 + k) * 1024 + i * 256 + lane * 4);
#pragma unroll
        for (int k = 0; k < NR; ++k) { float ss = 0.f;
#pragma unroll
            for (int i = 0; i < 4; ++i) ss += v[k][i][0] * v[k][i][0] + v[k][i][1] * v[k][i][1] + v[k][i][2] * v[k][i][2] + v[k][i][3] * v[k][i][3];
            ss = wsum(ss); const float rs = rsqrtf(ss * (1.0f / 1024.0f) + 1e-6f);
#pragma unroll
            for (int i = 0; i < 4; ++i) { u32x2 o; o[0] = pk2(v[k][i][0] * rs * g4[i][0], v[k][i][1] * rs * g4[i][1]); o[1] = pk2(v[k][i][2] * rs * g4[i][2], v[k][i][3] * rs * g4[i][3]);
                *(u32x2*)(h + (size_t)(r0 + k) * 1024 + i * 256 + lane * 4) = o; } }
    }
}
template <bool FINAL> __device__ __forceinline__ void phase_rmsnorm_bf(const Ctx cx, const bf16_t* __restrict__ xb, const float* __restrict__ g, bf16_t* __restrict__ h, float* __restrict__ out, int rows) {
    const int wv = cx.tid >> 6, lane = cx.tid & 63;
    constexpr int NR = 8;
    float gg[16];
#pragma unroll
    for (int i = 0; i < 2; ++i)
#pragma unroll
        for (int e = 0; e < 8; ++e) gg[i * 8 + e] = g[i * 512 + lane * 8 + e];
    for (int r0 = (cx.bx * 8 + wv) * NR; r0 < rows; r0 += cx.gd * 8 * NR) {
        u32x4 q[NR][2];
#pragma unroll
        for (int k = 0; k < NR; ++k)
#pragma unroll
            for (int i = 0; i < 2; ++i) q[k][i] = *(const u32x4*)(xb + (size_t)(r0 + k) * 1024 + i * 512 + lane * 8);
#pragma unroll
        for (int k = 0; k < NR; ++k) { float v[16]; float ss = 0.f;
#pragma unroll
            for (int i = 0; i < 2; ++i)
#pragma unroll
                for (int j = 0; j < 4; ++j) { v[i * 8 + 2 * j] = bflo(q[k][i][j]); v[i * 8 + 2 * j + 1] = bfhi(q[k][i][j]); ss += v[i * 8 + 2 * j] * v[i * 8 + 2 * j] + v[i * 8 + 2 * j + 1] * v[i * 8 + 2 * j + 1]; }
            ss = wsum(ss); const float rs = rsqrtf(ss * (1.0f / 1024.0f) + 1e-6f);
#pragma unroll
            for (int i = 0; i < 2; ++i) {
                if (FINAL) { float* op = out + (size_t)(r0 + k) * 1024 + i * 512 + lane * 8;
                    *(f32x4*)op = (f32x4){v[i * 8] * rs * gg[i * 8], v[i * 8 + 1] * rs * gg[i * 8 + 1], v[i * 8 + 2] * rs * gg[i * 8 + 2], v[i * 8 + 3] * rs * gg[i * 8 + 3]};
                    *(f32x4*)(op + 4) = (f32x4){v[i * 8 + 4] * rs * gg[i * 8 + 4], v[i * 8 + 5] * rs * gg[i * 8 + 5], v[i * 8 + 6] * rs * gg[i * 8 + 6], v[i * 8 + 7] * rs * gg[i * 8 + 7]}; }
                else { u32x4 o;
#pragma unroll
                    for (int j = 0; j < 4; ++j) o[j] = pk2(v[i * 8 + 2 * j] * rs * gg[i * 8 + 2 * j], v[i * 8 + 2 * j + 1] * rs * gg[i * 8 + 2 * j + 1]);
                    *(u32x4*)(h + (size_t)(r0 + k) * 1024 + i * 512 + lane * 8) = o; } } }
    }
}
__device__ __forceinline__ void phase_final_norm(const Ctx cx, float* x, const float* __restrict__ g, int rows) {
    const int wv = cx.tid >> 6, lane = cx.tid & 63;
    constexpr int NR = 4;
    f32x4 g4[4];
#pragma unroll
    for (int i = 0; i < 4; ++i) g4[i] = *(const f32x4*)(g + i * 256 + lane * 4);
    for (int r0 = (cx.bx * 8 + wv) * NR; r0 < rows; r0 += cx.gd * 8 * NR) {
        f32x4 v[NR][4];
#pragma unroll
        for (int k = 0; k < NR; ++k)
#pragma unroll
            for (int i = 0; i < 4; ++i) v[k][i] = *(const f32x4*)(x + (size_t)(r0 + k) * 1024 + i * 256 + lane * 4);
#pragma unroll
        for (int k = 0; k < NR; ++k) { float ss = 0.f;
#pragma unroll
            for (int i = 0; i < 4; ++i) ss += v[k][i][0] * v[k][i][0] + v[k][i][1] * v[k][i][1] + v[k][i][2] * v[k][i][2] + v[k][i][3] * v[k][i][3];
            ss = wsum(ss); const float rs = rsqrtf(ss * (1.0f / 1024.0f) + 1e-6f);
#pragma unroll
            for (int i = 0; i < 4; ++i) *(f32x4*)(x + (size_t)(r0 + k) * 1024 + i * 256 + lane * 4) = v[k][i] * rs * g4[i]; }
    }
}

__device__ __forceinline__ void phase_prep(const Ctx cx, KP p, int l, int grp) {
    unsigned char* ws = p->ws;
    const bf16_t* P = (const bf16_t*)(ws + WS_P);
    bf16_t* CQN = (bf16_t*)(ws + WS_CQN); bf16_t* CKVN = (bf16_t*)(ws + WS_CKVN); bf16_t* KR = (bf16_t*)(ws + WS_KR); float* CS = (float*)(ws + WS_CS);
    bf16_t* RKV = (bf16_t*)(ws + WS_RKV); bf16_t* LIN = (bf16_t*)(ws + WS_LIN); float* KN = (float*)(ws + WS_KN);
    const int* positions = (const int*)p->in[1];
    const float* qg = p->in[5] + l * 384; const float* kvg = p->in[7] + l * 256;
    const float* mu = p->in[13] + l * 1920; const float* k_k = p->in[19] + l * 512;
    const int wv = cx.tid >> 6, lane = cx.tid & 63;
    const float inv_freq = 1.0f / powf(10000.0f, (float)(lane & 15) * (1.0f / 16.0f));
    for (int r = cx.bx * 8 + wv; r < TG; r += cx.gd * 8) {
        const bf16_t* pr = P + (size_t)r * NP;
        { float v[6]; float ss = 0.f;
#pragma unroll
          for (int i = 0; i < 3; ++i) { const unsigned w = *(const unsigned*)(pr + i * 128 + lane * 2); v[2 * i] = bflo(w); v[2 * i + 1] = bfhi(w); ss += v[2 * i] * v[2 * i] + v[2 * i + 1] * v[2 * i + 1]; }
          ss = wsum(ss); const float rs = rsqrtf(ss * (1.0f / 384.0f) + 1e-6f);
#pragma unroll
          for (int i = 0; i < 3; ++i) { const int c = i * 128 + lane * 2; *(unsigned*)(CQN + (size_t)r * 384 + c) = pk2(v[2 * i] * rs * qg[c], v[2 * i + 1] * rs * qg[c + 1]); } }
        { const u32x2 w = *(const u32x2*)(pr + 384 + lane * 4); float v[4] = {bflo(w[0]), bfhi(w[0]), bflo(w[1]), bfhi(w[1])};
          float ss = v[0] * v[0] + v[1] * v[1] + v[2] * v[2] + v[3] * v[3]; ss = wsum(ss); const float rs = rsqrtf(ss * (1.0f / 256.0f) + 1e-6f);
          const f32x4 g4 = *(const f32x4*)(kvg + lane * 4); u32x2 o; o[0] = pk2(v[0] * rs * g4[0], v[1] * rs * g4[1]); o[1] = pk2(v[2] * rs * g4[2], v[3] * rs * g4[3]);
          *(u32x2*)(CKVN + (size_t)r * 256 + lane * 4) = o; }
        if (lane < 16) {
          const float pos = (float)positions[(size_t)grp * TG + r];
          const float ang = pos * inv_freq; const float rev = __builtin_amdgcn_fractf(ang * 0.15915494309189535f);
          const float c = __builtin_amdgcn_cosf(rev), s = __builtin_amdgcn_sinf(rev);
          CS[(size_t)r * 32 + lane] = c; CS[(size_t)r * 32 + 16 + lane] = s; }
        { const bf16_t* pz = pr + OFF_RW; const int s = r & (SEQ - 1); const bool hasp = s > 0, hasn = s < SEQ - 1;
#pragma unroll
          for (int ig = 0; ig < 3; ++ig) {
              unsigned wz[5], wp[5], wn[5]; f32x2 m2[5];
#pragma unroll
              for (int j = 0; j < 5; ++j) { const int c = (ig * 5 + j) * 128 + lane * 2;
                  wz[j] = *(const unsigned*)(pz + c); wp[j] = hasp ? *(const unsigned*)(pz - NP + c) : 0u; wn[j] = hasn ? *(const unsigned*)(pz + NP + c) : 0u; m2[j] = *(const f32x2*)(mu + c); }
#pragma unroll
              for (int j = 0; j < 5; ++j) { const int i = ig * 5 + j;
                  const float z0 = bflo(wz[j]), z1 = bfhi(wz[j]);
                  const float y0 = z0 + m2[j][0] * (0.5f * (bflo(wp[j]) + bflo(wn[j])) - z0), y1 = z1 + m2[j][1] * (0.5f * (bfhi(wp[j]) + bfhi(wn[j])) - z1);
                  if (i < 12) { *(unsigned*)(RKV + ((size_t)r * 3 + (i >> 2)) * 512 + (i & 3) * 128 + lane * 2) = pk2(y0, y1);
                      if (i >= 4 && i < 8) { const int kc = (i - 4) * 128 + lane * 2; const float a = y0 * k_k[kc], b = y1 * k_k[kc + 1]; float ss = a * a + b * b;
                          ss = hsum32(ss);
                          const float inv = 1.0f / fmaxf(sqrtf(ss), 1e-12f); if ((lane & 31) == 0) KN[(size_t)r * 8 + (i - 4) * 2 + (lane >> 5)] = inv; } }
                  else if (i == 12) *(unsigned*)(LIN + (size_t)r * 384 + lane * 2) = pk2(tanhf_(y0), tanhf_(y1));
                  else if (i == 13) *(unsigned*)(LIN + (size_t)r * 384 + 128 + lane * 2) = pk2(y0, y1);
                  else *(unsigned*)(LIN + (size_t)r * 384 + 256 + lane * 2) = pk2(sigmoidf_(y0), sigmoidf_(y1)); } } }
    }
}

__device__ __forceinline__ void phase_sg(const Ctx cx, KP p, int l, unsigned char* smem) {
    unsigned char* ws = p->ws;
    const bf16_t* P = (const bf16_t*)(ws + WS_P); bf16_t* YB = (bf16_t*)(ws + WS_YB);
    const bf16_t* Wsg = (const bf16_t*)(ws + WS_WSG) + (size_t)l * 8 * 128 * 128;
    const float* lng = p->in[9] + l * 512; const float* lnb = p->in[10] + l * 512; const float* sgb = p->in[12] + l * 8 * 128;
    constexpr int VP = 520;
    bf16_t* vn = (bf16_t*)smem;
    const int tid = cx.tid, wv = tid >> 6, lane = tid & 63, l15 = lane & 15, g4 = lane >> 4;
    for (int it = cx.bx; it < TG / 128; it += cx.gd) {
        const int r0 = it * 128;
        __syncthreads();
        f32x4 ga = *(const f32x4*)(lng + lane * 8), gb = *(const f32x4*)(lng + lane * 8 + 4), ba = *(const f32x4*)(lnb + lane * 8), bb = *(const f32x4*)(lnb + lane * 8 + 4);
        for (int tb = 0; tb < 16; tb += 4) { u32x4 raw4[4];
#pragma unroll
          for (int q = 0; q < 4; ++q) raw4[q] = *(const u32x4*)(P + (size_t)(r0 + wv * 16 + tb + q) * NP + OFF_SG + 512 + lane * 8);
#pragma unroll
          for (int q = 0; q < 4; ++q) { const int t = wv * 16 + tb + q; const u32x4 raw = raw4[q];
            float x[8]; float sm = 0.f;
#pragma unroll
            for (int j = 0; j < 4; ++j) { x[2 * j] = gelu_tanh(bflo(raw[j])); x[2 * j + 1] = gelu_tanh(bfhi(raw[j])); sm += x[2 * j] + x[2 * j + 1]; }
            const float mean = wsum(sm) * (1.0f / 512.0f); float sq = 0.f;
#pragma unroll
            for (int j = 0; j < 8; ++j) { x[j] -= mean; sq += x[j] * x[j]; }
            const float rs = rsqrtf(wsum(sq) * (1.0f / 512.0f) + 1e-5f);
            u32x4 o; o[0] = pk2(x[0] * rs * ga[0] + ba[0], x[1] * rs * ga[1] + ba[1]); o[1] = pk2(x[2] * rs * ga[2] + ba[2], x[3] * rs * ga[3] + ba[3]);
            o[2] = pk2(x[4] * rs * gb[0] + bb[0], x[5] * rs * gb[1] + bb[1]); o[3] = pk2(x[6] * rs * gb[2] + bb[2], x[7] * rs * gb[3] + bb[3]);
            *(u32x4*)(vn + t * VP + lane * 8) = o; } }
        __syncthreads();
        const int gi = wv;
        for (int half = 0; half < 2; ++half) {
            f32x4 acc[4][4];
#pragma unroll
            for (int a = 0; a < 4; ++a)
#pragma unroll
                for (int b = 0; b < 4; ++b) acc[a][b] = (f32x4){0.f, 0.f, 0.f, 0.f};
#pragma unroll 1
            for (int ks = 0; ks < 4; ++ks) {
                bf16x8 af[4];
#pragma unroll
                for (int dt = 0; dt < 4; ++dt)
#pragma unroll
                    for (int j = 0; j < 8; ++j) af[dt][j] = (short)vn[(ks * 32 + g4 * 8 + j) * VP + gi * 64 + dt * 16 + l15];
#pragma unroll
                for (int mt = 0; mt < 4; ++mt) {
                    const bf16x8 bfr = *(const bf16x8*)(Wsg + ((size_t)gi * 128 + (half * 4 + mt) * 16 + l15) * 128 + ks * 32 + g4 * 8);
#pragma unroll
                    for (int dt = 0; dt < 4; ++dt) acc[mt][dt] = __builtin_amdgcn_mfma_f32_16x16x32_bf16(af[dt], bfr, acc[mt][dt], 0, 0, 0);
                }
            }
#pragma unroll
            for (int mt = 0; mt < 4; ++mt) { const int t = (half * 4 + mt) * 16 + l15; const float bias = sgb[gi * 128 + t];
#pragma unroll
                for (int dt = 0; dt < 4; ++dt) { const int d0 = gi * 64 + dt * 16 + g4 * 4;
                    const u32x2 uq = *(const u32x2*)(P + (size_t)(r0 + t) * NP + OFF_SG + d0);
                    u32x2 o; o[0] = pk2(gelu_tanh(bflo(uq[0])) * (acc[mt][dt][0] + bias), gelu_tanh(bfhi(uq[0])) * (acc[mt][dt][1] + bias));
                    o[1] = pk2(gelu_tanh(bflo(uq[1])) * (acc[mt][dt][2] + bias), gelu_tanh(bfhi(uq[1])) * (acc[mt][dt][3] + bias));
                    *(u32x2*)(YB + (size_t)(r0 + t) * 512 + d0) = o; } }
        }
    }
}

__device__ __forceinline__ bf16x8 pack4z(float a, float b, float c, float d) { u32x4 t; t[0] = pk2(a, b); t[1] = pk2(c, d); t[2] = 0u; t[3] = 0u; return __builtin_bit_cast(bf16x8, t); }
__device__ __forceinline__ void phase_scan(const Ctx cx, KP p, int l, unsigned char* smem) {
    unsigned char* ws = p->ws;
    const bf16_t* __restrict__ RKV = (const bf16_t*)(ws + WS_RKV); const bf16_t* __restrict__ LOUT = (const bf16_t*)(ws + WS_LOUT); const float* __restrict__ KN = (const float*)(ws + WS_KN);
    bf16_t* __restrict__ YD = (bf16_t*)(ws + WS_YD);
    constexpr int KP2 = 72, VP2 = 24, SP2 = 72, CH = 16, NCH = SEQ / CH;
    constexpr int OPB_BYTES = 256 + 4 * 16 * KP2 * 2 + 3 * 64 * VP2 * 2;
    float* wl = (float*)smem;
    float* ybuf = wl + 1024;
    unsigned char* opb0 = smem + 8192;
    bf16_t* Sc = (bf16_t*)(opb0 + 2 * OPB_BYTES);
    const int tid = cx.tid, wv = tid >> 6, lane = tid & 63, l15 = lane & 15, g4 = lane >> 4;
    const bool is_prep = wv >= 4;
    const int j = lane, tq4 = wv - 4, it = wv;
    const int je = j & ~1; const bool jodd = (j & 1) != 0;
    const unsigned jsh = jodd ? 0u : 16u;
#define BSEL(W) __uint_as_float(((W) << jsh) & 0xffff0000u)
    for (int ci = cx.bx; ci < 2 * GBATCH * 8; ci += cx.gd) {
        const int dir = ci >> 7, bl = (ci >> 3) & 15, hh = ci & 7;
        const float kkw = (p->in[19] + l * 512)[hh * 64 + j], kaw = (p->in[20] + l * 512)[hh * 64 + j];
        __syncthreads();
        for (int idx = tid; idx < 64 * SP2 / 2; idx += NTHREADS) ((unsigned*)Sc)[idx] = 0u;
        f32x4 stS[4];
#pragma unroll
        for (int q = 0; q < 4; ++q) stS[q] = (f32x4){0.f, 0.f, 0.f, 0.f};
        f32x4 mS, mI, mT;
#pragma unroll
        for (int r = 0; r < 4; ++r) { const int s = 4 * g4 + r; mS[r] = (s < l15) ? 1.0f : 0.0f; mI[r] = (s <= l15) ? 1.0f : 0.0f; mT[r] = (l15 < s) ? 1.0f : 0.0f; }
        unsigned xr[4], xk[4], xv[4], xu[4], xa[4]; float xn[4];
        float w_[4], kk_[4], kd_[4], bb_[4], r_[4]; unsigned vraw_[4];
#define SCAN_FETCH(C) { _Pragma("unroll") for (int e = 0; e < 4; ++e) { const int stp = (C) * CH + 4 * tq4 + e; const size_t tok = (size_t)bl * SEQ + (dir ? (SEQ - 1 - stp) : stp); \
            xr[e] = *(const unsigned*)(RKV + (tok * 3 + 0) * 512 + hh * 64 + je); xk[e] = *(const unsigned*)(RKV + (tok * 3 + 1) * 512 + hh * 64 + je); xv[e] = *(const unsigned*)(RKV + (tok * 3 + 2) * 512 + hh * 64 + je); \
            xu[e] = *(const unsigned*)(LOUT + tok * 2560 + dir * 512 + hh * 64 + je); xa[e] = *(const unsigned*)(LOUT + tok * 2560 + 1024 + dir * 512 + hh * 64 + je); xn[e] = KN[tok * 8 + hh]; } }
#define SCAN_DECODE() { _Pragma("unroll") for (int e = 0; e < 4; ++e) { const float kf = BSEL(xk[e]), af = BSEL(xa[e]); w_[e] = 1.0f - BSEL(xu[e]); kk_[e] = kf * kkw * xn[e]; kd_[e] = kf * (1.0f + (af - 1.0f) * kaw); bb_[e] = kk_[e] * af; \
            r_[e] = BSEL(xr[e]); vraw_[e] = (xv[e] << jsh) >> 16; wl[(4 * tq4 + e) * 64 + j] = w_[e]; } }
#define SCAN_OPERANDS(BUF) { unsigned char* ob_ = opb0 + (BUF) * OPB_BYTES; float* pc_ = (float*)ob_; bf16_t* KKT_ = (bf16_t*)(ob_ + 256); bf16_t* RT_ = KKT_ + 16 * KP2; bf16_t* KDI_ = RT_ + 16 * KP2; bf16_t* BBI_ = KDI_ + 16 * KP2; \
            bf16_t* KDCT_ = BBI_ + 16 * KP2; bf16_t* NBBCT_ = KDCT_ + 64 * VP2; bf16_t* Vs_ = NBBCT_ + 64 * VP2; \
            float gp_[4]; \
            _Pragma("unroll") for (int gq = 0; gq < 4; ++gq) gp_[gq] = (wl[(4 * gq) * 64 + j] * wl[(4 * gq + 1) * 64 + j]) * (wl[(4 * gq + 2) * 64 + j] * wl[(4 * gq + 3) * 64 + j]); \
            const float g01_ = gp_[0] * gp_[1]; const float pr = g01_ * (gp_[2] * gp_[3]); \
            const float pa = tq4 == 0 ? 1.0f : (tq4 == 1 ? gp_[0] : (tq4 == 2 ? g01_ : g01_ * gp_[2])); \
            float pprev = pa; \
            _Pragma("unroll") for (int e = 0; e < 4; ++e) { const int t = 4 * tq4 + e; const float ptv = pprev * w_[e]; const float ip = __builtin_amdgcn_rcpf(ptv); const float kdi = kd_[e] * ip, bbi = bb_[e] * ip; \
                const unsigned c1_ = pk2(kk_[e] * pprev, r_[e] * ptv), c2_ = pk2(kdi, bbi), c3_ = pk2(kdi * pr, -bbi * pr); \
                KKT_[t * KP2 + j] = (bf16_t)(c1_ & 0xffffu); RT_[t * KP2 + j] = (bf16_t)(c1_ >> 16); KDI_[t * KP2 + j] = (bf16_t)(c2_ & 0xffffu); BBI_[t * KP2 + j] = (bf16_t)(c2_ >> 16); \
                KDCT_[j * VP2 + t] = (bf16_t)(c3_ & 0xffffu); NBBCT_[j * VP2 + t] = (bf16_t)(c3_ >> 16); Vs_[j * VP2 + t] = (bf16_t)vraw_[e]; pprev = ptv; } \
            if (tq4 == 0) pc_[j] = pr; }
        if (is_prep) { SCAN_FETCH(0) SCAN_DECODE() }
        lds_barrier();
        if (is_prep) { SCAN_FETCH(1) SCAN_OPERANDS(0) }
        lds_barrier();
#pragma unroll 1
        for (int c = 0; c < NCH; ++c) {
            if (is_prep) {
                if (c + 1 < NCH) { SCAN_DECODE() }
                lds_barrier();
                if (c + 2 < NCH) { SCAN_FETCH(c + 2) }
                if (c + 1 < NCH) { SCAN_OPERANDS((c + 1) & 1) }
                lds_barrier();
                if (tid < 256 + 128) { const int t = (tid - 256) >> 3, ig = tid & 7; const int stp = c * CH + t; const size_t tok = (size_t)bl * SEQ + (dir ? (SEQ - 1 - stp) : stp);
                    const f32x4 y0 = *(const f32x4*)(ybuf + t * 64 + ig * 8), y1 = *(const f32x4*)(ybuf + t * 64 + ig * 8 + 4);
                    u32x4 o; o[0] = pk2(y0[0], y0[1]); o[1] = pk2(y0[2], y0[3]); o[2] = pk2(y1[0], y1[1]); o[3] = pk2(y1[2], y1[3]);
                    *(u32x4*)(YD + ((size_t)dir * TG + tok) * 512 + hh * 64 + ig * 8) = o; }
            } else {
                const unsigned char* ob = opb0 + (c & 1) * OPB_BYTES; const float* pc = (const float*)ob; const bf16_t* KKT = (const bf16_t*)(ob + 256); const bf16_t* RT = KKT + 16 * KP2;
                const bf16_t* KDI = RT + 16 * KP2; const bf16_t* BBI = KDI + 16 * KP2; const bf16_t* KDCT = BBI + 16 * KP2; const bf16_t* NBBCT = KDCT + 64 * VP2; const bf16_t* Vs = NBBCT + 64 * VP2;
                f32x4 M1 = (f32x4){0.f, 0.f, 0.f, 0.f}, M2 = M1, N1 = M1, N2 = M1, XK = M1, XR = M1, M2T = M1;
#pragma unroll
                for (int ks = 0; ks < 2; ++ks) { const int off = l15 * KP2 + ks * 32 + g4 * 8;
                    const bf16x8 kdif = *(const bf16x8*)(KDI + off), bbif = *(const bf16x8*)(BBI + off), kktf = *(const bf16x8*)(KKT + off), rtf = *(const bf16x8*)(RT + off);
                    const bf16x8 sf = *(const bf16x8*)(Sc + (16 * it + l15) * SP2 + ks * 32 + g4 * 8);
                    M1 = __builtin_amdgcn_mfma_f32_16x16x32_bf16(kdif, kktf, M1, 0, 0, 0); M2 = __builtin_amdgcn_mfma_f32_16x16x32_bf16(bbif, kktf, M2, 0, 0, 0);
                    M2T = __builtin_amdgcn_mfma_f32_16x16x32_bf16(kktf, bbif, M2T, 0, 0, 0);
                    N1 = __builtin_amdgcn_mfma_f32_16x16x32_bf16(kdif, rtf, N1, 0, 0, 0); N2 = __builtin_amdgcn_mfma_f32_16x16x32_bf16(bbif, rtf, N2, 0, 0, 0);
                    XK = __builtin_amdgcn_mfma_f32_16x16x32_bf16(kktf, sf, XK, 0, 0, 0); XR = __builtin_amdgcn_mfma_f32_16x16x32_bf16(rtf, sf, XR, 0, 0, 0); }
                const u32x2 vq = *(const u32x2*)(Vs + (16 * it + l15) * VP2 + 4 * g4);
                u32x2 kaq[4], kbq[4]; f32x4 pcv[4];
#pragma unroll
                for (int q = 0; q < 4; ++q) { const int jrow = 16 * q + l15; kaq[q] = *(const u32x2*)(KDCT + jrow * VP2 + 4 * g4); kbq[q] = *(const u32x2*)(NBBCT + jrow * VP2 + 4 * g4); pcv[q] = *(const f32x4*)(pc + 16 * q + 4 * g4); }
                lds_barrier();
                M1 *= mS; M2 *= mS; N1 *= mI; N2 *= mI; M2T *= mT;
                const f32x4 Z4 = (f32x4){0.f, 0.f, 0.f, 0.f};
                f32x4 Id;
#pragma unroll
                for (int r = 0; r < 4; ++r) Id[r] = (4 * g4 + r == l15) ? 1.0f : 0.0f;
#define PK4(X) pack4z((X)[0], (X)[1], (X)[2], (X)[3])
#define MM(A_, B_) __builtin_amdgcn_mfma_f32_16x16x32_bf16(PK4(A_), PK4(B_), Z4, 0, 0, 0)
                const f32x4 P2 = MM(M2T, M2), P2T = MM(M2, M2T);
                const f32x4 P4 = MM(P2T, P2), P4T = MM(P2, P2T);
                const f32x4 P8 = MM(P4T, P4);
                const f32x4 a1 = Id + P4T, b1w = Id + P8, a2 = Id + P2, b2u = Id - M2T;
                const f32x4 Wm = MM(a1, b1w);
                const f32x4 UT = MM(a2, b2u);
                const f32x4 Tm = MM(UT, Wm);
#undef MM
                const bf16x8 AT = PK4(Tm);
                u32x4 b1; b1[0] = vq[0]; b1[1] = vq[1]; b1[2] = 0u; b1[3] = 0u;
                const f32x4 W1 = __builtin_amdgcn_mfma_f32_16x16x32_bf16(PK4(M1), __builtin_bit_cast(bf16x8, b1), XK, 0, 0, 0);
                const f32x4 SA = __builtin_amdgcn_mfma_f32_16x16x32_bf16(AT, PK4(W1), Z4, 0, 0, 0);
#undef PK4
                u32x4 bfq; bfq[0] = vq[0]; bfq[1] = vq[1]; bfq[2] = pk2(SA[0], SA[1]); bfq[3] = pk2(SA[2], SA[3]);
                const bf16x8 Bf = __builtin_bit_cast(bf16x8, bfq);
                { u32x4 a3; a3[0] = pk2(N1[0], N1[1]); a3[1] = pk2(N1[2], N1[3]); a3[2] = pk2(-N2[0], -N2[1]); a3[3] = pk2(-N2[2], -N2[3]);
                  const f32x4 Y = __builtin_amdgcn_mfma_f32_16x16x32_bf16(__builtin_bit_cast(bf16x8, a3), Bf, XR, 0, 0, 0);
#pragma unroll
                  for (int r = 0; r < 4; ++r) ybuf[(4 * g4 + r) * 64 + 16 * it + l15] = Y[r]; }
#pragma unroll
                for (int q = 0; q < 4; ++q) {
                    u32x4 a4; a4[0] = kaq[q][0]; a4[1] = kaq[q][1]; a4[2] = kbq[q][0]; a4[3] = kbq[q][1];
                    stS[q] = __builtin_amdgcn_mfma_f32_16x16x32_bf16(__builtin_bit_cast(bf16x8, a4), Bf, stS[q] * pcv[q], 0, 0, 0);
                    u32x2 sw; sw[0] = pk2(stS[q][0], stS[q][1]); sw[1] = pk2(stS[q][2], stS[q][3]);
                    *(u32x2*)(Sc + (16 * it + l15) * SP2 + 16 * q + 4 * g4) = sw; }
                lds_barrier();
            }
        }
#undef SCAN_FETCH
#undef SCAN_DECODE
#undef SCAN_OPERANDS
    }
#undef BSEL
}

__device__ __forceinline__ void phase_rwpost(const Ctx cx, KP p, int l) {
    unsigned char* ws = p->ws;
    const bf16_t* __restrict__ RKV = (const bf16_t*)(ws + WS_RKV); const bf16_t* __restrict__ LOUT = (const bf16_t*)(ws + WS_LOUT); const bf16_t* __restrict__ YD = (const bf16_t*)(ws + WS_YD);
    bf16_t* __restrict__ YC = (bf16_t*)(ws + WS_YC);
    const int wv = cx.tid >> 6, lane = cx.tid & 63; const int ch = lane * 8;
    float ka[8], rk[8], lg[8], lb[8];
#pragma unroll
    for (int e = 0; e < 8; ++e) { ka[e] = (p->in[20] + l * 512)[ch + e]; rk[e] = (p->in[21] + l * 512)[ch + e]; lg[e] = (p->in[22] + l * 512)[ch + e]; lb[e] = (p->in[23] + l * 512)[ch + e]; }
    for (int r = cx.bx * 8 + wv; r < TG; r += cx.gd * 8) {
        const u32x4 q0 = *(const u32x4*)(YD + (size_t)r * 512 + ch), q1 = *(const u32x4*)(YD + ((size_t)TG + r) * 512 + ch);
        const u32x4 qr = *(const u32x4*)(RKV + ((size_t)r * 3 + 0) * 512 + ch), qk = *(const u32x4*)(RKV + ((size_t)r * 3 + 1) * 512 + ch), qv = *(const u32x4*)(RKV + ((size_t)r * 3 + 2) * 512 + ch);
        const u32x4 qa0 = *(const u32x4*)(LOUT + (size_t)r * 2560 + 1024 + ch), qa1 = *(const u32x4*)(LOUT + (size_t)r * 2560 + 1536 + ch), qg = *(const u32x4*)(LOUT + (size_t)r * 2560 + 2048 + ch);
        float y[8], bt = 0.f, sm = 0.f;
#pragma unroll
        for (int j = 0; j < 4; ++j) { y[2 * j] = bflo(q0[j]) + bflo(q1[j]); y[2 * j + 1] = bfhi(q0[j]) + bfhi(q1[j]); sm += y[2 * j] + y[2 * j + 1];
            bt += bflo(qr[j]) * bflo(qk[j]) * rk[2 * j] * (2.0f + (bflo(qa0[j]) + bflo(qa1[j]) - 2.0f) * ka[2 * j]);
            bt += bfhi(qr[j]) * bfhi(qk[j]) * rk[2 * j + 1] * (2.0f + (bfhi(qa0[j]) + bfhi(qa1[j]) - 2.0f) * ka[2 * j + 1]); }
        const float mean = red8(sm) * (1.0f / 64.0f); float sq = 0.f;
#pragma unroll
        for (int e = 0; e < 8; ++e) { y[e] -= mean; sq += y[e] * y[e]; }
        const float rs = rsqrtf(red8(sq) * (1.0f / 64.0f) + 64e-5f); const float bonus = red8(bt);
        u32x4 o;
#pragma unroll
        for (int j = 0; j < 4; ++j) o[j] = pk2((y[2 * j] * rs * lg[2 * j] + lb[2 * j] + bonus * bflo(qv[j])) * bflo(qg[j]), (y[2 * j + 1] * rs * lg[2 * j + 1] + lb[2 * j + 1] + bonus * bfhi(qv[j])) * bfhi(qg[j]));
        *(u32x4*)(YC + (size_t)r * 512 + ch) = o;
    }
}

__device__ __forceinline__ void phase_attn(const Ctx cx, KP p, unsigned char* smem) {
    unsigned char* ws = p->ws;
    const bf16_t* __restrict__ Q = (const bf16_t*)(ws + WS_Q); const bf16_t* __restrict__ KV = (const bf16_t*)(ws + WS_KV); const bf16_t* __restrict__ KR = (const bf16_t*)(ws + WS_KR); bf16_t* __restrict__ YA = (bf16_t*)(ws + WS_YA);
    constexpr int KP_ = 104, VTP = 72, BUFE = 64 * KP_ + 64 * VTP;
    bf16_t* lb = (bf16_t*)smem;
    const int tid = cx.tid, wv = tid >> 6, lane = tid & 63, l15 = lane & 15, g4 = lane >> 4;
    const int skey = tid >> 3, sch = tid & 7, skey2 = (tid & 255) >> 2, sch2 = tid & 3;
    const int vcol = skey ^ (sch << 3);
    for (int item0 = cx.bx; item0 < GBATCH * 8 * 8; item0 += cx.gd) {
        int item = item0;
        if (cx.gd == 256) { const int x = cx.bx & 7, li = (cx.bx >> 3) + 32 * (item0 >> 8); item = (((li >> 3) * 8 + x) << 3) | (li & 7); }
        const int qb = item & 7, hh = (item >> 3) & 7, bl = item >> 6;
        const size_t rb = (size_t)bl * SEQ; const size_t q0 = rb + qb * 256 + wv * 32;
        bf16x8 qf[2][3];
#pragma unroll
        for (int qt = 0; qt < 2; ++qt)
#pragma unroll
            for (int ks = 0; ks < 3; ++ks) qf[qt][ks] = *(const bf16x8*)(Q + (q0 + qt * 16 + l15) * 768 + hh * 96 + ks * 32 + g4 * 8);
        f32x4 o[2][4], osum[2]; float mrun[2] = {-1e30f, -1e30f};
        osum[0] = (f32x4){0.f, 0.f, 0.f, 0.f}; osum[1] = osum[0];
#pragma unroll
        for (int a = 0; a < 2; ++a)
#pragma unroll
            for (int b = 0; b < 4; ++b) o[a][b] = (f32x4){0.f, 0.f, 0.f, 0.f};
        u32x4 gk = *(const u32x4*)(KV + (rb + skey) * 1024 + hh * 128 + sch * 8);
        u32x4 gv = *(const u32x4*)(KV + (rb + skey) * 1024 + hh * 128 + 64 + sch * 8);
        u32x4 gr = *(const u32x4*)(KR + (rb + skey2) * 32 + sch2 * 8);
        __syncthreads();
#define ATT_STAGE(BUF) { bf16_t* Ks_ = lb + (BUF) * BUFE; bf16_t* Vt_ = Ks_ + 64 * KP_; \
            *(u32x4*)(Ks_ + skey * KP_ + sch * 8) = gk; if (tid < 256) *(u32x4*)(Ks_ + skey2 * KP_ + 64 + sch2 * 8) = gr; \
            _Pragma("unroll") for (int j = 0; j < 4; ++j) { Vt_[(sch * 8 + 2 * j) * VTP + vcol] = (bf16_t)(gv[j] & 0xffffu); Vt_[(sch * 8 + 2 * j + 1) * VTP + vcol] = (bf16_t)(gv[j] >> 16); } }
#define ATT_FETCH(KT) { const size_t kb = rb + (size_t)(KT) * 64; \
            gk = *(const u32x4*)(KV + (kb + skey) * 1024 + hh * 128 + sch * 8); gv = *(const u32x4*)(KV + (kb + skey) * 1024 + hh * 128 + 64 + sch * 8); \
            gr = *(const u32x4*)(KR + (kb + skey2) * 32 + sch2 * 8); }
        ATT_STAGE(0)
        ATT_FETCH(1)
        __syncthreads();
        for (int kt = 0; kt < SEQ / 64; ++kt) {
            if (kt + 1 < SEQ / 64) { ATT_STAGE((kt + 1) & 1) }
            if (kt + 2 < SEQ / 64) { ATT_FETCH(kt + 2) }
            const bf16_t* Ks = lb + (kt & 1) * BUFE; const bf16_t* Vt = Ks + 64 * KP_;
            f32x4 s[2][4];
#pragma unroll
            for (int a = 0; a < 2; ++a)
#pragma unroll
                for (int b = 0; b < 4; ++b) s[a][b] = (f32x4){0.f, 0.f, 0.f, 0.f};
#pragma unroll
            for (int k4 = 0; k4 < 4; ++k4)
#pragma unroll
                for (int ks = 0; ks < 3; ++ks) { const bf16x8 kf = *(const bf16x8*)(Ks + (k4 * 16 + l15) * KP_ + ks * 32 + g4 * 8);
#pragma unroll
                    for (int qt = 0; qt < 2; ++qt) s[qt][k4] = __builtin_amdgcn_mfma_f32_16x16x32_bf16(kf, qf[qt][ks], s[qt][k4], 0, 0, 0); }
            bf16x8 pf[2][2];
#pragma unroll
            for (int qt = 0; qt < 2; ++qt) {
                float mx = s[qt][0][0];
#pragma unroll
                for (int k4 = 0; k4 < 4; ++k4)
#pragma unroll
                    for (int j = 0; j < 4; ++j) mx = fmaxf(mx, s[qt][k4][j]);
                mx = max_swap32(max_swap16(mx));
                const float mn = fmaxf(mrun[qt], mx); const float al = __builtin_amdgcn_exp2f(mrun[qt] - mn); mrun[qt] = mn;
                unsigned pw[8];
#pragma unroll
                for (int k4 = 0; k4 < 4; ++k4) { float e[4];
#pragma unroll
                    for (int j = 0; j < 4; ++j) e[j] = __builtin_amdgcn_exp2f(s[qt][k4][j] - mn);
                    pw[k4 * 2] = pk2(e[0], e[1]); pw[k4 * 2 + 1] = pk2(e[2], e[3]); }
                if (__builtin_amdgcn_ballot_w64(al != 1.0f) != 0ull) {
#pragma unroll
                    for (int dt = 0; dt < 4; ++dt) o[qt][dt] *= al;
                    osum[qt] *= al; }
#pragma unroll
                for (int ks2 = 0; ks2 < 2; ++ks2) { u32x4 t; t[0] = pw[ks2 * 4]; t[1] = pw[ks2 * 4 + 1]; t[2] = pw[ks2 * 4 + 2]; t[3] = pw[ks2 * 4 + 3]; pf[qt][ks2] = __builtin_bit_cast(bf16x8, t); }
            }
            { u32x4 t1; const unsigned one2 = (l15 == 0) ? 0x3F803F80u : 0u; t1[0] = one2; t1[1] = one2; t1[2] = one2; t1[3] = one2; const bf16x8 vones = __builtin_bit_cast(bf16x8, t1);
#pragma unroll
              for (int ks2 = 0; ks2 < 2; ++ks2)
#pragma unroll
                  for (int qt = 0; qt < 2; ++qt) osum[qt] = __builtin_amdgcn_mfma_f32_16x16x32_bf16(vones, pf[qt][ks2], osum[qt], 0, 0, 0); }
#pragma unroll
            for (int dt = 0; dt < 4; ++dt) { const int vrow = (dt * 16 + l15) * VTP, vsw = (dt * 2 + (l15 >> 3)) << 3;
#pragma unroll
                for (int ks2 = 0; ks2 < 2; ++ks2) {
                    const u32x2 lo = *(const u32x2*)(Vt + vrow + (((2 * ks2) * 16 + g4 * 4) ^ vsw)), hi = *(const u32x2*)(Vt + vrow + (((2 * ks2 + 1) * 16 + g4 * 4) ^ vsw));
                    u32x4 t; t[0] = lo[0]; t[1] = lo[1]; t[2] = hi[0]; t[3] = hi[1]; const bf16x8 vf = __builtin_bit_cast(bf16x8, t);
#pragma unroll
                    for (int qt = 0; qt < 2; ++qt) o[qt][dt] = __builtin_amdgcn_mfma_f32_16x16x32_bf16(vf, pf[qt][ks2], o[qt][dt], 0, 0, 0); } }
            lds_barrier();
        }
#undef ATT_STAGE
#undef ATT_FETCH
#pragma unroll
        for (int qt = 0; qt < 2; ++qt) { const float lt = __shfl(osum[qt][0], l15); const float inv = 1.0f / lt;
#pragma unroll
            for (int dt = 0; dt < 4; ++dt) { u32x2 w; w[0] = pk2(o[qt][dt][0] * inv, o[qt][dt][1] * inv); w[1] = pk2(o[qt][dt][2] * inv, o[qt][dt][3] * inv);
                *(u32x2*)(YA + (q0 + qt * 16 + l15) * 512 + hh * 64 + dt * 16 + g4 * 4) = w; } }
    }
}

constexpr int NS = 19;
constexpr int N_PHASES = 1 + NL * NGRP * NS;
__device__ __forceinline__ bool stage_needs_sync(int st) { return !(st == 2 || st == 4 || st == 5 || st == 7 || st == 9 || st == 11 || st == 12); }

__global__ void __launch_bounds__(NTHREADS, 2) mega(Params pdummy) {
    extern __shared__ __attribute__((aligned(16))) unsigned char smem[];
    cg::grid_group grid = cg::this_grid();
    LAS unsigned char* lds = (LAS unsigned char*)smem;
    int ph_lo, ph_hi; XcdBarrier xbar;
    { KP p0 = get_kp(); ph_lo = p0->ph_lo; ph_hi = p0->ph_hi;
      volatile LAS unsigned* stw = (volatile LAS unsigned*)(lds + LDS_MAIN);
      if (threadIdx.x == 0) { stw[0] = 0u; stw[1] = 0u; }
      __syncthreads();
      xbar.bar = (unsigned*)(p0->ws + WS_BAR); xbar.x = xb_xcc_id(); xbar.st = stw;
      if (threadIdx.x == 0) (void)xb_add(&xbar.bar[XB_XCNT(xbar.x)], 1u); }
    bool repeated = false;
#pragma unroll 1
    for (int ph = ph_lo; ph < ph_hi;) {
        bool need_sync = true, again = false;
        Ctx cx; cx.tid = (int)threadIdx.x; cx.bx = (int)blockIdx.x; cx.gd = (int)gridDim.x; asm volatile("" : "+v"(cx.tid), "+s"(cx.bx), "+s"(cx.gd));
        const int G = cx.gd, bx = cx.bx;
        if (ph == 0) { KP p = get_kp(); phase_convert(cx, p, smem); }
        else {
            const int q = ph - 1; const int grp = q / (NL * NS), l = (q / NS) % NL, st = q % NS;
            need_sync = stage_needs_sync(st) && !(st == 18 && l != NL - 1);
            const size_t xoff = (size_t)grp * TG * 1024;
#define GETP KP p = get_kp(); unsigned char* ws = p->ws; (void)ws;
            if (REPEAT_MASK != 0 && ((REPEAT_MASK >> st) & 1) && !repeated) again = true;
            int ste = st; if ((st == 9 || st == 10) && ((bx >> 3) & 1)) ste = 19 - st;
            if ((st == 7 || st == 8) && ((bx >> 3) & 1)) ste = 15 - st;
            switch (ste) {
            case 0: { GETP
                if (l == 0) phase_rmsnorm(cx, p->in[0] + xoff, p->in[2] + l * 1024, (bf16_t*)(ws + WS_H), TG);
                else phase_rmsnorm_bf<false>(cx, (const bf16_t*)(ws + WS_XB), p->in[2] + l * 1024, (bf16_t*)(ws + WS_H), nullptr, TG); } break;
            case 1: { GETP
                pg8::Gemm g{(const bf16_t*)(ws + WS_H), (const bf16_t*)(ws + WS_WIN + l * SZ_WIN), TG, NPP, 1024, 1024}; pg8::StaticOrder S; S.init(TG, NPP, G, bx);
                pg8::EpiStore E{(bf16_t*)(ws + WS_P), NP, NP}; pg8::gemm_phase(cx, lds, g, S, E); } break;
            case 2: { GETP phase_prep(cx, p, l, grp); } break;
            case 3: { GETP phase_sg(cx, p, l, smem); } break;
            case 4: { GETP
                pg8::Gemm g{(const bf16_t*)(ws + WS_CQN), (const bf16_t*)(ws + WS_WUQ + l * SZ_WUQ), TG, 768, 384, 384}; pg8::StaticOrder S; S.init(TG, 768, G, bx);
                pg8::EpiQ E{(bf16_t*)(ws + WS_Q), (const float*)(ws + WS_CS)}; pg8::gemm_phase(cx, lds, g, S, E); } break;
            case 5: { GETP
                pg8::Gemm g{(const bf16_t*)(ws + WS_CKVN), (const bf16_t*)(ws + WS_WUKV + l * SZ_WUKV), TG, 1024, 256, 256}; pg8::StaticOrder S; S.init(TG, 1024, G, bx);
                pg8::EpiStore E{(bf16_t*)(ws + WS_KV), 1024, 1024}; pg8::gemm_phase(cx, lds, g, S, E);
                { pg8::Gemm g2{(const bf16_t*)(ws + WS_H), (const bf16_t*)(ws + WS_WKR + l * SZ_WKR), TG, 256, 1024, 1024}; pg8::StaticOrder S2; S2.init(TG, 256, G, (bx + G / 2) % G);
                  pg8::EpiKR E2{(bf16_t*)(ws + WS_KR), (const float*)(ws + WS_CS)}; pg8::gemm_phase(cx, lds, g2, S2, E2); } } break;
            case 6: { GETP
                { pg8::Gemm g{(const bf16_t*)(ws + WS_LIN), (const bf16_t*)(ws + WS_WLORA + l * SZ_WLORA), TG, 2048, 256, 384}; pg8::StaticOrder S; S.init(TG, 2048, G, bx);
                  pg8::EpiLora E{(bf16_t*)(ws + WS_LOUT), p->in[14] + l * 1024, p->in[16] + l * 1024, 0}; pg8::gemm_phase(cx, lds, g, S, E); }
                { pg8::Gemm g{(const bf16_t*)(ws + WS_LIN) + 128, (const bf16_t*)(ws + WS_WLORA + l * SZ_WLORA) + (size_t)2048 * 256, TG, 512, 256, 384}; pg8::StaticOrder S; S.init(TG, 512, G, bx);
                  pg8::EpiLora E{(bf16_t*)(ws + WS_LOUT), p->in[14] + l * 1024, p->in[16] + l * 1024, 2048}; pg8::gemm_phase(cx, lds, g, S, E); } } break;
            case 7: { GETP phase_scan(cx, p, l, smem); } break;
            case 8: { GETP phase_attn(cx, p, smem); } break;
            case 9: { GETP phase_rwpost(cx, p, l); } break;
            case 10: { GETP
                pg8::Gemm g{(const bf16_t*)(ws + WS_H), (const bf16_t*)(ws + WS_WG + l * SZ_WG), TG, 3072, 1024, 1024}; pg8::StaticOrder S; S.init(TG, 3072, G, bx);
                pg8::EpiGate E{(bf16_t*)(ws + WS_P), p->in[4] + l * 3072}; pg8::gemm_phase(cx, lds, g, S, E); } break;
            case 11: case 12: case 13: { GETP
                const int nb = st - 11;
                pg8::Gemm g{(const bf16_t*)(ws + WS_YA) + (size_t)nb * TG * 512, (const bf16_t*)(ws + WS_WBR + l * SZ_WBR) + (size_t)nb * 1024 * 512, TG, 1024, 512, 512};
                pg8::StaticOrder S; S.init(TG, 1024, G, bx); pg8::EpiBranch E{(bf16_t*)(ws + WS_KV), (const bf16_t*)(ws + WS_P), nb}; pg8::gemm_phase(cx, lds, g, S, E); } break;
            case 14: { GETP
                pg8::Gemm g{(const bf16_t*)(ws + WS_KV), (const bf16_t*)(ws + WS_WOUT + l * SZ_WOUT), TG, 1024, 1024, 1024}; pg8::StaticOrder S; S.init(TG, 1024, G, bx);
                if (l == 0) { pg8::EpiResidB<true> E{p->in[0] + xoff, nullptr, (bf16_t*)(ws + WS_XB)}; pg8::gemm_phase(cx, lds, g, S, E); }
                else { pg8::EpiResidB<false> E{nullptr, (const bf16_t*)(ws + WS_XB), (bf16_t*)(ws + WS_XB)}; pg8::gemm_phase(cx, lds, g, S, E); } } break;
            case 15: { GETP phase_rmsnorm_bf<false>(cx, (const bf16_t*)(ws + WS_XB), p->in[26] + l * 1024, (bf16_t*)(ws + WS_H), nullptr, TG); } break;
            case 16: { GETP
                pg8::Gemm g{(const bf16_t*)(ws + WS_H), (const bf16_t*)(ws + WS_WGU + l * SZ_WGU), TG, 5632, 1024, 1024}; pg8::StaticOrder S; S.init(TG, 5632, G, bx);
                pg8::EpiGU E{(bf16_t*)(ws + WS_P)}; pg8::gemm_phase(cx, lds, g, S, E); } break;
            case 17: { GETP
                pg8::Gemm g{(const bf16_t*)(ws + WS_P), (const bf16_t*)(ws + WS_WDN + l * SZ_WDN), TG, 1024, DFF, DFF}; pg8::StaticOrder S; S.init(TG, 1024, G, bx);
                pg8::EpiResidB<false> E{nullptr, (const bf16_t*)(ws + WS_XB), (bf16_t*)(ws + WS_XB)}; pg8::gemm_phase(cx, lds, g, S, E); } break;
            default: { GETP
                if (l == NL - 1) phase_rmsnorm_bf<true>(cx, (const bf16_t*)(ws + WS_XB), p->in[30], nullptr, p->out + xoff, TG); } break;
            }
        }
        if (again) { repeated = true; __syncthreads(); continue; }
        repeated = false;
        if (ph + 1 < ph_hi) { if (!need_sync) __syncthreads(); else if (ph == 0) grid.sync(); else xcd_barrier(xbar, cx.tid, (unsigned)cx.gd); }
        ++ph;
    }
}

extern "C" void kernel_launch(void* const* d_in, const int* in_sizes, int n_in, void* d_out, int out_size, void* d_ws, size_t ws_size, hipStream_t stream) {
    static int grid_blocks = 0;
    if (grid_blocks == 0) {
        if (n_in != 31 || out_size != TT * DM || ws_size < WS_END2) { fprintf(stderr, "kernel_launch: unexpected shapes (n_in %d out %d ws %zu need %zu)\n", n_in, out_size, ws_size, (size_t)WS_END2); grid_blocks = -1; return; }
        int dev = 0, cus = 0, per_cu = 0;
        hipGetDevice(&dev); hipDeviceGetAttribute(&cus, hipDeviceAttributeMultiprocessorCount, dev);
        if (hipFuncSetAttribute((const void*)mega, hipFuncAttributeMaxDynamicSharedMemorySize, LDS_BYTES) != hipSuccess) { fprintf(stderr, "kernel_launch: hipFuncSetAttribute failed\n"); grid_blocks = -1; return; }
        if (hipOccupancyMaxActiveBlocksPerMultiprocessor(&per_cu, (const void*)mega, NTHREADS, LDS_BYTES) != hipSuccess || per_cu < 1) { fprintf(stderr, "kernel_launch: occupancy query gave %d\n", per_cu); per_cu = 1; (void)hipGetLastError(); }
        grid_blocks = cus * per_cu;
    }
    if (grid_blocks < 0) return;
    Params p{};
    for (int i = 0; i < 31; ++i) p.in[i] = (const float*)d_in[i];
    p.out = (float*)d_out; p.ws = (unsigned char*)d_ws;
#if ONE_LAUNCH
    (void)hipMemsetAsync((unsigned char*)d_ws + WS_BAR, 0, XCD_BAR_WORDS_C * 4, stream);
    p.ph_lo = 0; p.ph_hi = N_PHASES;
    void* args[] = {&p};
    hipError_t e = hipLaunchCooperativeKernel((const void*)mega, dim3(grid_blocks), dim3(NTHREADS), args, LDS_BYTES, stream);
    if (e != hipSuccess) fprintf(stderr, "cooperative launch failed: %s (grid %d)\n", hipGetErrorString(e), grid_blocks);
#else
    for (int ph = 0; ph < N_PHASES; ++ph) { p.ph_lo = ph; p.ph_hi = ph + 1; hipLaunchKernelGGL(mega, dim3(grid_blocks), dim3(NTHREADS), LDS_BYTES, stream, p); }
#endif
}
```

```cpp
#include <hip/hip_runtime.h>
#include <hip/hip_cooperative_groups.h>
#include <cstdio>
namespace cg = cooperative_groups;

#define LAS __attribute__((address_space(3)))
typedef unsigned short bf16_t;
typedef short bf16x8 __attribute__((ext_vector_type(8)));
typedef float f32x4 __attribute__((ext_vector_type(4)));
typedef float f32x2 __attribute__((ext_vector_type(2)));
typedef unsigned u32x4 __attribute__((ext_vector_type(4)));
typedef unsigned u32x2 __attribute__((ext_vector_type(2)));

#ifndef REPEAT_MASK
#define REPEAT_MASK 0
#endif
#ifndef ONE_LAUNCH
#define ONE_LAUNCH 1
#endif

constexpr int DM = 1024, NB = 32, SEQ = 2048, NL = 2;
constexpr int TT = NB * SEQ;
constexpr int NGRP = 2;
constexpr int TG = TT / NGRP;
constexpr int GBATCH = NB / NGRP;
constexpr int NIN = 6688, NP = 3584, NPP = 3584;
constexpr int OFF_SG = 640, OFF_RW = 1664;
constexpr int DFF = 2816;
constexpr int LDS_MAIN = 136 * 1024;
constexpr int LDS_BYTES = LDS_MAIN + 16;
constexpr int XCD_BAR_WORDS_C = 3456;
constexpr int NTHREADS = 512;

constexpr size_t al256(size_t x) { return (x + 255) & ~(size_t)255; }
constexpr size_t SZ_WIN = (size_t)NPP * 1024 * 2, SZ_WG = (size_t)3072 * 1024 * 2, SZ_WUQ = (size_t)768 * 384 * 2, SZ_WUKV = (size_t)1024 * 256 * 2,
                 SZ_WLORA = (size_t)2560 * 384 * 2, SZ_WBR = (size_t)3 * 1024 * 512 * 2, SZ_WOUT = (size_t)1024 * 1024 * 2,
                 SZ_WGU = (size_t)5632 * 1024 * 2, SZ_WDN = (size_t)1024 * 2816 * 2, SZ_WSG = (size_t)8 * 128 * 128 * 2;
constexpr size_t WS_WIN = 0;
constexpr size_t WS_WG = WS_WIN + NL * SZ_WIN;
constexpr size_t WS_WUQ = WS_WG + NL * SZ_WG;
constexpr size_t WS_WUKV = WS_WUQ + NL * SZ_WUQ;
constexpr size_t WS_WLORA = WS_WUKV + NL * SZ_WUKV;
constexpr size_t WS_WBR = WS_WLORA + NL * SZ_WLORA;
constexpr size_t WS_WOUT = WS_WBR + NL * SZ_WBR;
constexpr size_t WS_WGU = WS_WOUT + NL * SZ_WOUT;
constexpr size_t WS_WDN = WS_WGU + NL * SZ_WGU;
constexpr size_t WS_WSG = WS_WDN + NL * SZ_WDN;
constexpr size_t SZ_WKR = (size_t)256 * 1024 * 2;
constexpr size_t WS_WKR = al256(WS_WSG + NL * SZ_WSG);
constexpr size_t WS_H = al256(WS_WKR + NL * SZ_WKR);
constexpr size_t WS_P = WS_H + (size_t)TG * 1024 * 2;
constexpr size_t WS_Q = WS_P + (size_t)TG * NP * 2;
constexpr size_t WS_KV = WS_Q + (size_t)TG * 768 * 2;
constexpr size_t WS_KR = WS_KV + (size_t)TG * 1024 * 2;
constexpr size_t WS_CS = WS_KR + (size_t)TG * 32 * 2;
constexpr size_t WS_YA = WS_CS + (size_t)TG * 32 * 4;
constexpr size_t WS_YB = WS_YA + (size_t)TG * 512 * 2;
constexpr size_t WS_YC = WS_YB + (size_t)TG * 512 * 2;
constexpr size_t WS_LIN = WS_YC + (size_t)TG * 512 * 2;
constexpr size_t WS_RKV = WS_LIN + (size_t)TG * 384 * 2;
constexpr size_t WS_KN = WS_RKV + (size_t)TG * 1536 * 2;
constexpr size_t WS_LOUT = WS_KN + (size_t)TG * 8 * 4;
constexpr size_t WS_YD = WS_LOUT + (size_t)TG * 2560 * 2;
constexpr size_t WS_CQN = WS_YD;
constexpr size_t WS_CKVN = WS_YD + (size_t)TG * 384 * 2;
constexpr size_t WS_XB = al256(WS_YD + (size_t)2 * TG * 512 * 2);
constexpr size_t WS_END = WS_XB + (size_t)TG * 1024 * 2;
constexpr size_t WS_BAR = al256(WS_END);
constexpr size_t WS_END2 = WS_BAR + XCD_BAR_WORDS_C * 4;
static_assert(WS_END2 <= ((size_t)1 << 30), "workspace map exceeds 1 GiB");

struct Ctx { int tid, bx, gd; };
__device__ __forceinline__ float bf2f(unsigned b) { return __uint_as_float(b << 16); }
__device__ __forceinline__ float bflo(unsigned w) { return __uint_as_float(w << 16); }
__device__ __forceinline__ float bfhi(unsigned w) { return __uint_as_float(w & 0xffff0000u); }
typedef __bf16 bf16x2_t __attribute__((ext_vector_type(2)));
__device__ __forceinline__ unsigned pk2(float lo, float hi) { const f32x2 v = {lo, hi}; const bf16x2_t b = __builtin_convertvector(v, bf16x2_t); return __builtin_bit_cast(unsigned, b); }
__device__ __forceinline__ unsigned f2bf(float f) { return pk2(f, 0.0f); }
__device__ __forceinline__ float sigmoidf_(float x) { return __builtin_amdgcn_rcpf(1.0f + __expf(-x)); }
__device__ __forceinline__ float tanhf_(float y) { return 1.0f - 2.0f * __builtin_amdgcn_rcpf(__expf(2.0f * y) + 1.0f); }
__device__ __forceinline__ float gelu_tanh(float x) { return 0.5f * x * (1.0f + tanhf_(0.7978845608028654f * (x + 0.044715f * x * x * x))); }
__device__ __forceinline__ void lds_barrier() { asm volatile("s_waitcnt lgkmcnt(0)" ::: "memory"); __builtin_amdgcn_s_barrier(); asm volatile("" ::: "memory"); }
template <int CTRL> __device__ __forceinline__ float dppf(float v) { return __int_as_float(__builtin_amdgcn_update_dpp(0, __float_as_int(v), CTRL, 0xF, 0xF, true)); }
__device__ __forceinline__ float red16(float v) {
    v += dppf<0xB1>(v);
    v += dppf<0x4E>(v);
    v += dppf<0x141>(v);
    v += dppf<0x140>(v);
    return v;
}


__device__ __forceinline__ float sum_swap16(float v) { const auto r = __builtin_amdgcn_permlane16_swap(__float_as_uint(v), __float_as_uint(v), false, false); return __uint_as_float(r[0]) + __uint_as_float(r[1]); }
__device__ __forceinline__ float sum_swap32(float v) { const auto r = __builtin_amdgcn_permlane32_swap(__float_as_uint(v), __float_as_uint(v), false, false); return __uint_as_float(r[0]) + __uint_as_float(r[1]); }
__device__ __forceinline__ float max_swap16(float v) { const auto r = __builtin_amdgcn_permlane16_swap(__float_as_uint(v), __float_as_uint(v), false, false); return fmaxf(__uint_as_float(r[0]), __uint_as_float(r[1])); }
__device__ __forceinline__ float max_swap32(float v) { const auto r = __builtin_amdgcn_permlane32_swap(__float_as_uint(v), __float_as_uint(v), false, false); return fmaxf(__uint_as_float(r[0]), __uint_as_float(r[1])); }
__device__ __forceinline__ float wsum(float v) { return sum_swap32(sum_swap16(red16(v))); }
__device__ __forceinline__ float hsum32(float v) { return sum_swap16(red16(v)); }
__device__ __forceinline__ float red8(float v) { v += dppf<0xB1>(v); v += dppf<0x4E>(v); v += dppf<0x141>(v); return v; }

#define XB_TMO      128
#define XB_XCNT(j)  (256  + 64 * (j))
#define XB_XSUB(j)  (1280 + 64 * (j))
#define XB_XGEN(j)  (2304 + 64 * (j))
#define XB_TOP      3328
#define XB_TOPGEN   3392
#define XCD_BAR_WORDS 3456
#define XB_SPIN_CAP (1u << 22)
__device__ __forceinline__ unsigned xb_ld(unsigned* p)              { return __hip_atomic_load(p, __ATOMIC_RELAXED, __HIP_MEMORY_SCOPE_AGENT); }
__device__ __forceinline__ unsigned xb_add(unsigned* p, unsigned v) { return __hip_atomic_fetch_add(p, v, __ATOMIC_RELAXED, __HIP_MEMORY_SCOPE_AGENT); }
__device__ __forceinline__ unsigned xb_xcc_id() { return (unsigned)__builtin_amdgcn_s_getreg((3 << 11) | 20) & 0xFu; }
#define XB_SPIN(cond, bar) do { unsigned _sp = 0; while (cond) { __builtin_amdgcn_s_sleep(1); \
    if ((++_sp & 255u) == 0u) { if (xb_ld(&(bar)[XB_TMO])) break; if (_sp > XB_SPIN_CAP) { atomicAdd(&(bar)[XB_TMO], 1u); break; } } } } while (0)
struct XcdBarrier { unsigned* bar; unsigned x; volatile LAS unsigned* st; };
__device__ __forceinline__ void xcd_barrier_complete(unsigned* bar, unsigned x, unsigned G, unsigned& nloc, unsigned& nx) {
    unsigned sum, cnt, mine, sp = 0u;
    for (;;) {
        sum = 0u; cnt = 0u; mine = 0u;
#pragma unroll
        for (unsigned j = 0; j < 16; ++j) { const unsigned c = xb_ld(&bar[XB_XCNT(j)]); sum += c; cnt += (c > 0u) ? 1u : 0u; mine = (j == x) ? c : mine; }
        if (sum == G) break;
        __builtin_amdgcn_s_sleep(1);
        if ((++sp & 255u) == 0u) { if (xb_ld(&bar[XB_TMO])) break; if (sp > XB_SPIN_CAP) { atomicAdd(&bar[XB_TMO], 1u); break; } }
    }
    nloc = mine > 0u ? mine : 1u; nx = cnt > 0u ? cnt : 1u;
}
__device__ __forceinline__ void xcd_barrier(const XcdBarrier& b, int tid, unsigned G) {
    asm volatile("s_waitcnt vmcnt(0)" ::: "memory");
    __syncthreads();
    if (tid == 0) {
        unsigned* bar = b.bar;
        __builtin_amdgcn_s_waitcnt(0);
        unsigned nloc = b.st[0], nx = b.st[1];
        if (nloc == 0u) { xcd_barrier_complete(bar, b.x, G, nloc, nx); b.st[0] = nloc; b.st[1] = nx; }
        const unsigned old = xb_add(&bar[XB_XSUB(b.x)], 1u);
        const unsigned gen = old / nloc;
        if (old + 1u == (gen + 1u) * nloc) {
            __builtin_amdgcn_fence(__ATOMIC_RELEASE, "agent");
            asm volatile("s_waitcnt vmcnt(0)" ::: "memory");
            const unsigned og = xb_add(&bar[XB_TOP], 1u);
            const unsigned tg = og / nx;
            if (og + 1u == (tg + 1u) * nx) xb_add(&bar[XB_TOPGEN], 1u);
            else XB_SPIN(xb_ld(&bar[XB_TOPGEN]) == tg, bar);
            __builtin_amdgcn_fence(__ATOMIC_ACQUIRE, "agent");
            xb_add(&bar[XB_XGEN(b.x)], 1u);
            asm volatile("s_waitcnt vmcnt(0)" ::: "memory");
        } else {
            XB_SPIN(xb_ld(&bar[XB_XGEN(b.x)]) == gen, bar);
            __builtin_amdgcn_fence(__ATOMIC_ACQUIRE, "agent");
            asm volatile("s_waitcnt vmcnt(0)" ::: "memory");
        }
    }
    __syncthreads();
}

namespace pg8 {
constexpr int BM = 256, BK = 64, HALF = 128, HTB = HALF * BK * 2, STAGE_BYTES = 8 * HTB, NXCD = 8, WGM = 8;
__host__ __device__ __forceinline__ int lds_byte(int r, int c) { const int st = (r >> 4) * 2 + (c >> 5), rr = r & 15, cc = c & 31, ob = rr * 64 + cc * 2; return st * 1024 + (ob ^ (((ob >> 9) & 1) << 5)); }
__host__ __device__ __forceinline__ void stage_rc(int b, int& R, int& C) { const int st = b / 1024, sb = b % 1024, swz = sb ^ (((sb >> 9) & 1) << 5); R = (st >> 1) * 16 + swz / 64; C = (st & 1) * 32 + (swz % 64) / 2; }
__host__ __device__ __forceinline__ int perm32(int rho) { const int n = rho >> 4, i = rho & 15; return 8 * (i >> 2) + 4 * n + (i & 3); }
struct Unit { int pm, pn; };
struct Gemm { const bf16_t* A; const bf16_t* Bt; int M, N, K, lda; };
struct StaticOrder {
    int nM, nN, nwg, G, c;
    __device__ void init(int M, int N, int G_, int c_) { nM = M / BM; nN = N / BM; nwg = nM * nN; G = G_; c = c_; }
    __device__ bool next(int i, Unit& u) const {
        const long L = (long)i * G + c; if (L >= nwg) return false;
        int wgid = (int)L; { const int q = nwg / NXCD, r = nwg % NXCD, xcd = wgid % NXCD, off = wgid / NXCD; wgid = (xcd < r ? xcd * (q + 1) : r * (q + 1) + (xcd - r) * q) + off; }
        const int nig = WGM * nN, gid = wgid / nig, fm = gid * WGM, gsz = (nM - fm) < WGM ? (nM - fm) : WGM;
        u.pm = fm + ((wgid % nig) % gsz); u.pn = (wgid % nig) / gsz; return true;
    }
};
__device__ __forceinline__ unsigned cvt_pk_bf16(float lo, float hi) { return pk2(lo, hi); }

template <class Epi>
__device__ __forceinline__ void gemm_phase(const Ctx cx, LAS unsigned char* lds, const Gemm g, const StaticOrder& S, const Epi& E) {
    const int tid = cx.tid, wid = __builtin_amdgcn_readfirstlane(tid >> 6), lane = tid & 63, wr = wid >> 2, wc = wid & 3, fr = lane & 15, fq = lane >> 4;
    int K = g.K, lda = g.lda; asm volatile("" : "+s"(K), "+s"(lda));
    const int nt = K / BK;
    unsigned voffA[2], voffB[2];
#pragma unroll
    for (int i = 0; i < 2; ++i) { int R, C; stage_rc(tid * 16 + i * 8192, R, C); const int Rb = Epi::PERM ? ((R & ~31) + perm32(R & 31)) : R;
        voffA[i] = (unsigned)(R * lda + C) * 2u; voffB[i] = (unsigned)(Rb * K + C) * 2u; }
    const size_t kstep = (size_t)(BK * 2);
    const size_t hstepA = (size_t)HALF * lda * 2, hstepB = (size_t)HALF * K * 2;
    const size_t tstepA = 2 * hstepA, tstepB = 2 * hstepB;
    const unsigned ldsw = (unsigned)wid * 1024u;
    const int aoff = lds_byte(wr * 64 + fr, fq * 8), boff = lds_byte(wc * 32 + fr, fq * 8);
#define PG8_SA(b, h) (((b) * 2 + (h)) * HTB)
#define PG8_SB(b, h) ((4 + (b) * 2 + (h)) * HTB)
#define PG8_STAGE(bufoff, gbase, voff) do { _Pragma("unroll") for (int _i = 0; _i < 2; ++_i) \
        __builtin_amdgcn_global_load_lds((const unsigned*)((const char*)(gbase) + (voff)[_i]), (LAS unsigned*)(lds + (bufoff) + ldsw + _i * 8192), 16, 0, 0); } while (0)
#define PG8_LDA(dst, b, h) do { _Pragma("unroll") for (int m = 0; m < 4; ++m) _Pragma("unroll") for (int k = 0; k < 2; ++k) dst[m][k] = *(const LAS bf16x8*)(lds + PG8_SA(b, h) + aoff + m * 2048 + k * 1024); } while (0)
#define PG8_LDB(dst, b, h) do { _Pragma("unroll") for (int n = 0; n < 2; ++n) _Pragma("unroll") for (int k = 0; k < 2; ++k) dst[n][k] = *(const LAS bf16x8*)(lds + PG8_SB(b, h) + boff + n * 2048 + k * 1024); } while (0)
#define PG8_MMA(ai, bj, At, Bt) do { __builtin_amdgcn_s_setprio(1); _Pragma("unroll") for (int m = 0; m < 4; ++m) _Pragma("unroll") for (int n = 0; n < 2; ++n) _Pragma("unroll") for (int k = 0; k < 2; ++k) \
        acc[ai][bj][m][n] = __builtin_amdgcn_mfma_f32_16x16x32_bf16(Bt[n][k], At[m][k], acc[ai][bj][m][n], 0, 0, 0); __builtin_amdgcn_s_setprio(0); } while (0)
#define PG8_WAIT_V(n) asm volatile("s_waitcnt vmcnt(" #n ")" ::: "memory")
#define PG8_WAIT_L(n) asm volatile("s_waitcnt lgkmcnt(" #n ")" ::: "memory")
#define PG8_BAR __builtin_amdgcn_s_barrier()
#define PG8_SCHED __builtin_amdgcn_sched_barrier(0)
    Unit cur, nxt; int ui = 0;
    if (!S.next(0, cur)) return;
    f32x4 acc[2][2][4][2];
#pragma unroll
    for (int a = 0; a < 2; ++a)
#pragma unroll
        for (int b = 0; b < 2; ++b)
#pragma unroll
            for (int m = 0; m < 4; ++m)
#pragma unroll
                for (int n = 0; n < 2; ++n) acc[a][b][m][n] = (f32x4){0.f, 0.f, 0.f, 0.f};
    bf16x8 At[4][2], B0[2][2], B1[2][2];
    const char* cA = (const char*)g.A + (size_t)cur.pm * tstepA; const char* cB = (const char*)g.Bt + (size_t)cur.pn * tstepB;
    PG8_STAGE(PG8_SB(0, 0), cB, voffB); PG8_STAGE(PG8_SA(0, 0), cA, voffA); PG8_STAGE(PG8_SB(0, 1), cB + hstepB, voffB); PG8_STAGE(PG8_SA(0, 1), cA + hstepA, voffA);
    if (wr == 1) PG8_BAR;
    PG8_WAIT_V(4); PG8_BAR;
    PG8_STAGE(PG8_SB(1, 0), cB + kstep, voffB); PG8_STAGE(PG8_SA(1, 0), cA + kstep, voffA); PG8_STAGE(PG8_SB(1, 1), cB + hstepB + kstep, voffB);
    PG8_WAIT_V(6); PG8_BAR;
    for (;;) {
        const bool has_next = S.next(ui + 1, nxt);
        const char* nA = has_next ? (const char*)g.A + (size_t)nxt.pm * tstepA : cA; const char* nB = has_next ? (const char*)g.Bt + (size_t)nxt.pn * tstepB : cB;
#pragma unroll 1
        for (int t = 0; t < nt; t += 2) {
            const bool last = (t == nt - 2);
            const char* a1 = cA + (size_t)(t + 1) * kstep;
            const char* a2 = last ? nA : cA + (size_t)(t + 2) * kstep; const char* b2 = last ? nB : cB + (size_t)(t + 2) * kstep;
            const char* a3 = a2 + kstep; const char* b3 = b2 + kstep;
            PG8_LDB(B0, 0, 0); PG8_SCHED; PG8_LDA(At, 0, 0); PG8_STAGE(PG8_SA(1, 1), a1 + hstepA, voffA);
            PG8_WAIT_L(8); PG8_BAR; PG8_WAIT_L(0); PG8_MMA(0, 0, At, B0); PG8_BAR; PG8_SCHED;
            PG8_LDB(B1, 0, 1); PG8_STAGE(PG8_SB(0, 0), b2, voffB);
            PG8_BAR; PG8_WAIT_L(0); PG8_MMA(0, 1, At, B1); PG8_BAR;
            PG8_LDA(At, 0, 1); PG8_STAGE(PG8_SA(0, 0), a2, voffA);
            PG8_BAR; PG8_WAIT_L(0); PG8_MMA(1, 0, At, B0); PG8_BAR; PG8_SCHED;
            PG8_STAGE(PG8_SB(0, 1), b2 + hstepB, voffB);
            PG8_WAIT_V(6); PG8_BAR; PG8_MMA(1, 1, At, B1); PG8_BAR;
            PG8_LDB(B0, 1, 0); PG8_SCHED; PG8_LDA(At, 1, 0); PG8_STAGE(PG8_SA(0, 1), a2 + hstepA, voffA);
            PG8_WAIT_L(8); PG8_BAR; PG8_WAIT_L(0); PG8_MMA(0, 0, At, B0); PG8_BAR; PG8_SCHED;
            PG8_LDB(B1, 1, 1); PG8_STAGE(PG8_SB(1, 0), b3, voffB);
            PG8_BAR; PG8_WAIT_L(0); PG8_MMA(0, 1, At, B1); PG8_BAR;
            PG8_LDA(At, 1, 1); PG8_STAGE(PG8_SA(1, 0), a3, voffA);
            PG8_BAR; PG8_WAIT_L(0); PG8_MMA(1, 0, At, B0); PG8_BAR; PG8_SCHED;
            PG8_STAGE(PG8_SB(1, 1), b3 + hstepB, voffB);
            PG8_WAIT_V(6); PG8_BAR; PG8_MMA(1, 1, At, B1); PG8_BAR;
        }
        E(acc, cur, wr, wc, fr, fq);
        if (!has_next) break;
#pragma unroll
        for (int a = 0; a < 2; ++a)
#pragma unroll
            for (int b = 0; b < 2; ++b)
#pragma unroll
                for (int m = 0; m < 4; ++m)
#pragma unroll
                    for (int n = 0; n < 2; ++n) acc[a][b][m][n] = (f32x4){0.f, 0.f, 0.f, 0.f};
        cur = nxt; cA = nA; cB = nB; ++ui;
    }
    PG8_WAIT_V(0);
    if (wr == 0) PG8_BAR;
    PG8_BAR;
#undef PG8_SA
#undef PG8_SB
#undef PG8_STAGE
#undef PG8_LDA
#undef PG8_LDB
#undef PG8_MMA
#undef PG8_WAIT_V
#undef PG8_WAIT_L
#undef PG8_BAR
#undef PG8_SCHED
}

#define EPI_ARGS const f32x4 (&acc)[2][2][4][2], const Unit& u, int wr, int wc, int fr, int fq
#define FOR_AIM _Pragma("unroll") for (int ai = 0; ai < 2; ++ai) _Pragma("unroll") for (int m = 0; m < 4; ++m)

struct EpiStore {
    static constexpr bool PERM = true;
    bf16_t* O; int ldc; int ncols;
    __device__ __forceinline__ void operator()(EPI_ARGS) const {
        const int row0 = u.pm * BM + wr * 64 + fr, col0 = u.pn * BM + wc * 32 + 8 * fq;
        FOR_AIM { const int row = row0 + ai * HALF + m * 16;
#pragma unroll
            for (int bj = 0; bj < 2; ++bj) { const int col = col0 + bj * HALF; if (col < ncols) {
                const f32x4 v0 = acc[ai][bj][m][0], v1 = acc[ai][bj][m][1];
                u32x4 o; o[0] = cvt_pk_bf16(v0[0], v0[1]); o[1] = cvt_pk_bf16(v0[2], v0[3]); o[2] = cvt_pk_bf16(v1[0], v1[1]); o[3] = cvt_pk_bf16(v1[2], v1[3]);
                *(u32x4*)(O + (size_t)row * ldc + col) = o; } } }
    }
};
struct EpiQ {
    static constexpr bool PERM = false;
    bf16_t* O; const float* cs;
    __device__ __forceinline__ void operator()(EPI_ARGS) const {
        const float QS = 0.10206207261596575f * 1.4426950408889634f;
        const int row0 = u.pm * BM + wr * 64 + fr;
#pragma unroll
        for (int bj = 0; bj < 2; ++bj) { const int cb = u.pn * BM + bj * HALF + wc * 32; const bool rope = (cb % 96) == 64;
            FOR_AIM { const int row = row0 + ai * HALF + m * 16;
                f32x4 v0 = acc[ai][bj][m][0] * QS, v1 = acc[ai][bj][m][1] * QS;
                if (rope) { const f32x4 c4 = *(const f32x4*)(cs + (size_t)row * 32 + 4 * fq), s4 = *(const f32x4*)(cs + (size_t)row * 32 + 16 + 4 * fq);
                    const f32x4 o0 = v0 * c4 - v1 * s4, o1 = v0 * s4 + v1 * c4; v0 = o0; v1 = o1; }
                u32x2 a, b; a[0] = cvt_pk_bf16(v0[0], v0[1]); a[1] = cvt_pk_bf16(v0[2], v0[3]); b[0] = cvt_pk_bf16(v1[0], v1[1]); b[1] = cvt_pk_bf16(v1[2], v1[3]);
                *(u32x2*)(O + (size_t)row * 768 + cb + 4 * fq) = a; *(u32x2*)(O + (size_t)row * 768 + cb + 16 + 4 * fq) = b; } }
    }
};
struct EpiKR {
    static constexpr bool PERM = false;
    bf16_t* O; const float* cs;
    __device__ __forceinline__ void operator()(EPI_ARGS) const {
        if (u.pn != 0 || wc != 0) return;
        const int row0 = u.pm * BM + wr * 64 + fr;
        FOR_AIM { const int row = row0 + ai * HALF + m * 16;
            const f32x4 v0 = acc[ai][0][m][0], v1 = acc[ai][0][m][1];
            const f32x4 c4 = *(const f32x4*)(cs + (size_t)row * 32 + 4 * fq), s4 = *(const f32x4*)(cs + (size_t)row * 32 + 16 + 4 * fq);
            const f32x4 o0 = v0 * c4 - v1 * s4, o1 = v0 * s4 + v1 * c4;
            u32x2 a, b; a[0] = cvt_pk_bf16(o0[0], o0[1]); a[1] = cvt_pk_bf16(o0[2], o0[3]); b[0] = cvt_pk_bf16(o1[0], o1[1]); b[1] = cvt_pk_bf16(o1[2], o1[3]);
            *(u32x2*)(O + (size_t)row * 32 + 4 * fq) = a; *(u32x2*)(O + (size_t)row * 32 + 16 + 4 * fq) = b; }
    }
};
struct EpiLora {
    static constexpr bool PERM = true;
    bf16_t* O; const float* w0; const float* a0; int cbase;
    __device__ __forceinline__ void operator()(EPI_ARGS) const {
        const int row0 = u.pm * BM + wr * 64 + fr, col0 = cbase + u.pn * BM + wc * 32 + 8 * fq;
        const int tcol = cbase + u.pn * BM; const int kind = tcol < 1024 ? 0 : (tcol < 2048 ? 1 : 2);
#pragma unroll
        for (int bj = 0; bj < 2; ++bj) { const int col = col0 + bj * HALF;
            f32x4 b0 = (f32x4){0.f, 0.f, 0.f, 0.f}, b1 = b0;
            if (kind == 0) { b0 = *(const f32x4*)(w0 + col); b1 = *(const f32x4*)(w0 + col + 4); }
            else if (kind == 1) { b0 = *(const f32x4*)(a0 + col - 1024); b1 = *(const f32x4*)(a0 + col - 1020); }
            FOR_AIM { const int row = row0 + ai * HALF + m * 16;
                f32x4 v0 = acc[ai][bj][m][0] + b0, v1 = acc[ai][bj][m][1] + b1;
                if (kind == 0) {
#pragma unroll
                    for (int j = 0; j < 4; ++j) { v0[j] = 1.0f - __expf(-0.6065306597126334f * sigmoidf_(v0[j])); v1[j] = 1.0f - __expf(-0.6065306597126334f * sigmoidf_(v1[j])); } }
                else if (kind == 1) {
#pragma unroll
                    for (int j = 0; j < 4; ++j) { v0[j] = sigmoidf_(v0[j]); v1[j] = sigmoidf_(v1[j]); } }
                u32x4 o; o[0] = cvt_pk_bf16(v0[0], v0[1]); o[1] = cvt_pk_bf16(v0[2], v0[3]); o[2] = cvt_pk_bf16(v1[0], v1[1]); o[3] = cvt_pk_bf16(v1[2], v1[3]);
                *(u32x4*)(O + (size_t)row * 2560 + col) = o; } }
    }
};
struct EpiGate {
    static constexpr bool PERM = true;
    bf16_t* O; const float* bias;
    __device__ __forceinline__ void operator()(EPI_ARGS) const {
        const int row0 = u.pm * BM + wr * 64 + fr, col0 = u.pn * BM + wc * 32 + 8 * fq;
#pragma unroll
        for (int bj = 0; bj < 2; ++bj) { const int col = col0 + bj * HALF;
            const f32x4 b0 = *(const f32x4*)(bias + col) * -1.4426950408889634f, b1 = *(const f32x4*)(bias + col + 4) * -1.4426950408889634f;
            FOR_AIM { const int row = row0 + ai * HALF + m * 16;
                f32x4 v0, v1;
#pragma unroll
                for (int j = 0; j < 4; ++j) { v0[j] = __builtin_amdgcn_rcpf(1.0f + __builtin_amdgcn_exp2f(__builtin_fmaf(acc[ai][bj][m][0][j], -1.4426950408889634f, b0[j])));
                                              v1[j] = __builtin_amdgcn_rcpf(1.0f + __builtin_amdgcn_exp2f(__builtin_fmaf(acc[ai][bj][m][1][j], -1.4426950408889634f, b1[j]))); }
                u32x4 o; o[0] = cvt_pk_bf16(v0[0], v0[1]); o[1] = cvt_pk_bf16(v0[2], v0[3]); o[2] = cvt_pk_bf16(v1[0], v1[1]); o[3] = cvt_pk_bf16(v1[2], v1[3]);
                *(u32x4*)(O + (size_t)row * 3072 + col) = o; } }
    }
};
struct EpiBranch {
    static constexpr bool PERM = true;
    bf16_t* MG; const bf16_t* G; int nb;
    __device__ __forceinline__ void operator()(EPI_ARGS) const {
        const int row0 = u.pm * BM + wr * 64 + fr, col0 = u.pn * BM + wc * 32 + 8 * fq;
        FOR_AIM { const int row = row0 + ai * HALF + m * 16;
#pragma unroll
            for (int bj = 0; bj < 2; ++bj) { const int col = col0 + bj * HALF;
                const u32x4 gq = *(const u32x4*)(G + (size_t)row * 3072 + nb * 1024 + col);
                const f32x4 a0 = acc[ai][bj][m][0], a1 = acc[ai][bj][m][1];
                float v[8];
                v[0] = bflo(gq[0]) * a0[0]; v[1] = bfhi(gq[0]) * a0[1]; v[2] = bflo(gq[1]) * a0[2]; v[3] = bfhi(gq[1]) * a0[3];
                v[4] = bflo(gq[2]) * a1[0]; v[5] = bfhi(gq[2]) * a1[1]; v[6] = bflo(gq[3]) * a1[2]; v[7] = bfhi(gq[3]) * a1[3];
                bf16_t* dst = MG + (size_t)row * 1024 + col;
                if (nb > 0) { const u32x4 mq = *(const u32x4*)dst;
#pragma unroll
                    for (int j = 0; j < 4; ++j) { v[2 * j] += bflo(mq[j]); v[2 * j + 1] += bfhi(mq[j]); } }
                u32x4 o; o[0] = cvt_pk_bf16(v[0], v[1]); o[1] = cvt_pk_bf16(v[2], v[3]); o[2] = cvt_pk_bf16(v[4], v[5]); o[3] = cvt_pk_bf16(v[6], v[7]);
                *(u32x4*)dst = o; } }
    }
};
struct EpiResid {
    static constexpr bool PERM = false;
    const float* xin; float* xout;
    __device__ __forceinline__ void operator()(EPI_ARGS) const {
        const int row0 = u.pm * BM + wr * 64 + fr, col0 = u.pn * BM + wc * 32 + 4 * fq;
        FOR_AIM { const size_t ro = (size_t)(row0 + ai * HALF + m * 16) * 1024 + col0;
#pragma unroll
            for (int bj = 0; bj < 2; ++bj)
#pragma unroll
                for (int n = 0; n < 2; ++n) { const size_t o = ro + bj * HALF + n * 16; *(f32x4*)(xout + o) = *(const f32x4*)(xin + o) + acc[ai][bj][m][n]; } }
    }
};
template <bool IN_F32> struct EpiResidB {
    static constexpr bool PERM = true;
    const float* xin32; const bf16_t* xinb; bf16_t* xout;
    __device__ __forceinline__ void operator()(EPI_ARGS) const {
        const int row0 = u.pm * BM + wr * 64 + fr, col0 = u.pn * BM + wc * 32 + 8 * fq;
        FOR_AIM { const int row = row0 + ai * HALF + m * 16;
#pragma unroll
            for (int bj = 0; bj < 2; ++bj) { const size_t o = (size_t)row * 1024 + col0 + bj * HALF;
                const f32x4 a0 = acc[ai][bj][m][0], a1 = acc[ai][bj][m][1]; float v[8];
                if (IN_F32) { const f32x4 x0 = *(const f32x4*)(xin32 + o), x1 = *(const f32x4*)(xin32 + o + 4);
#pragma unroll
                    for (int j = 0; j < 4; ++j) { v[j] = x0[j] + a0[j]; v[4 + j] = x1[j] + a1[j]; } }
                else { const u32x4 xq = *(const u32x4*)(xinb + o);
                    v[0] = bflo(xq[0]) + a0[0]; v[1] = bfhi(xq[0]) + a0[1]; v[2] = bflo(xq[1]) + a0[2]; v[3] = bfhi(xq[1]) + a0[3];
                    v[4] = bflo(xq[2]) + a1[0]; v[5] = bfhi(xq[2]) + a1[1]; v[6] = bflo(xq[3]) + a1[2]; v[7] = bfhi(xq[3]) + a1[3]; }
                u32x4 w; w[0] = cvt_pk_bf16(v[0], v[1]); w[1] = cvt_pk_bf16(v[2], v[3]); w[2] = cvt_pk_bf16(v[4], v[5]); w[3] = cvt_pk_bf16(v[6], v[7]);
                *(u32x4*)(xout + o) = w; } }
    }
};
struct EpiGU {
    static constexpr bool PERM = true;
    bf16_t* O;
    __device__ __forceinline__ void operator()(EPI_ARGS) const {
        const int row0 = u.pm * BM + wr * 64 + fr, oc0 = u.pn * 128 + wc * 32 + 8 * fq;
        FOR_AIM { const int row = row0 + ai * HALF + m * 16; float v[8];
#pragma unroll
            for (int n = 0; n < 2; ++n) { const f32x4 gt = acc[ai][0][m][n], up = acc[ai][1][m][n];
#pragma unroll
                for (int j = 0; j < 4; ++j) v[4 * n + j] = gt[j] * sigmoidf_(gt[j]) * up[j]; }
            u32x4 o; o[0] = cvt_pk_bf16(v[0], v[1]); o[1] = cvt_pk_bf16(v[2], v[3]); o[2] = cvt_pk_bf16(v[4], v[5]); o[3] = cvt_pk_bf16(v[6], v[7]);
            *(u32x4*)(O + (size_t)row * DFF + oc0) = o; }
    }
};
}

template <class F> __device__ __forceinline__ void conv_t(const Ctx cx, float* tl, bf16_t* dst, int K, int N, F src) {
    const int tid = cx.tid; const int nk = K / 64, nn = N / 64, ntile = nk * nn;
    float rg[8];
    int t = cx.bx;
    if (t < ntile) { const int k0 = (t % nk) * 64, n0 = (t / nk) * 64;
#pragma unroll
        for (int i = 0; i < 8; ++i) rg[i] = src(k0 + (tid >> 6) + 8 * i, n0 + (tid & 63)); }
    for (; t < ntile; t += cx.gd) {
        const int k0 = (t % nk) * 64, n0 = (t / nk) * 64;
        lds_barrier();
#pragma unroll
        for (int i = 0; i < 8; ++i) tl[((tid >> 6) + 8 * i) * 65 + (tid & 63)] = rg[i];
        lds_barrier();
        const int tn = t + cx.gd;
        if (tn < ntile) { const int k1 = (tn % nk) * 64, n1 = (tn / nk) * 64;
#pragma unroll
            for (int i = 0; i < 8; ++i) rg[i] = src(k1 + (tid >> 6) + 8 * i, n1 + (tid & 63)); }
#pragma unroll
        for (int i = 0; i < 8; ++i) { const int n = (tid >> 6) + 8 * i, k = tid & 63; dst[(size_t)(n0 + n) * K + k0 + k] = (bf16_t)f2bf(tl[k * 65 + n]); }
    }
}

struct Params { const float* in[31]; float* out; unsigned char* ws; int ph_lo, ph_hi; };
typedef const __attribute__((opencl_constant)) Params* KP;
__device__ __forceinline__ KP get_kp() { auto k = __builtin_amdgcn_kernarg_segment_ptr(); asm volatile("" : "+s"(k)); return (KP)k; }

__device__ __forceinline__ void phase_convert(const Ctx cx, KP p, unsigned char* smem) {
    float* tl = (float*)smem; unsigned char* ws = p->ws;
    for (int l = 0; l < NL; ++l) {
        { const float* w = p->in[3] + (size_t)l * 1024 * NIN;
          conv_t(cx, tl, (bf16_t*)(ws + WS_WIN + l * SZ_WIN), 1024, NPP, [=](int k, int n) { return w[(size_t)k * NIN + (n < 640 ? n : n + 32)]; });
          conv_t(cx, tl, (bf16_t*)(ws + WS_WKR + l * SZ_WKR), 1024, 256, [=](int k, int n) { return n < 32 ? w[(size_t)k * NIN + 640 + n] : 0.0f; });
          conv_t(cx, tl, (bf16_t*)(ws + WS_WG + l * SZ_WG), 1024, 3072, [=](int k, int n) { return w[(size_t)k * NIN + 3616 + n]; }); }
        { const float* w = p->in[6] + (size_t)l * 384 * 768; conv_t(cx, tl, (bf16_t*)(ws + WS_WUQ + l * SZ_WUQ), 384, 768, [=](int k, int n) { return w[(size_t)k * 768 + n]; }); }
        { const float* w = p->in[8] + (size_t)l * 256 * 1024; conv_t(cx, tl, (bf16_t*)(ws + WS_WUKV + l * SZ_WUKV), 256, 1024, [=](int k, int n) { return w[(size_t)k * 1024 + n]; }); }
        { const float* w2 = p->in[15] + (size_t)l * 2 * 64 * 512; const float* a2 = p->in[17] + (size_t)l * 2 * 64 * 512; const float* g2 = p->in[18] + (size_t)l * 128 * 512;
          conv_t(cx, tl, (bf16_t*)(ws + WS_WLORA + l * SZ_WLORA), 256, 2048, [=](int k, int n) {
              const int blk = n >> 9, c = n & 511;
              if ((k >> 6) != blk) return 0.0f;
              return blk < 2 ? w2[(size_t)(blk * 64 + (k & 63)) * 512 + c] : a2[(size_t)((blk - 2) * 64 + (k & 63)) * 512 + c]; });
          conv_t(cx, tl, (bf16_t*)(ws + WS_WLORA + l * SZ_WLORA) + (size_t)2048 * 256, 256, 512, [=](int k, int n) { return k >= 128 ? g2[(size_t)(k - 128) * 512 + n] : 0.0f; }); }
        for (int nb = 0; nb < 3; ++nb) { const float* w = p->in[24] + (size_t)(l * 3 + nb) * 512 * 1024;
          conv_t(cx, tl, (bf16_t*)(ws + WS_WBR + l * SZ_WBR) + (size_t)nb * 1024 * 512, 512, 1024, [=](int k, int n) { return w[(size_t)k * 1024 + n]; }); }
        { const float* w = p->in[25] + (size_t)l * 1024 * 1024; conv_t(cx, tl, (bf16_t*)(ws + WS_WOUT + l * SZ_WOUT), 1024, 1024, [=](int k, int n) { return w[(size_t)k * 1024 + n]; }); }
        { const float* wg = p->in[27] + (size_t)l * 1024 * DFF; const float* wu = p->in[28] + (size_t)l * 1024 * DFF;
          conv_t(cx, tl, (bf16_t*)(ws + WS_WGU + l * SZ_WGU), 1024, 5632, [=](int k, int c) { const int j = (c >> 8) * 128 + (c & 127); return (c & 128) ? wu[(size_t)k * DFF + j] : wg[(size_t)k * DFF + j]; }); }
        { const float* w = p->in[29] + (size_t)l * DFF * 1024; conv_t(cx, tl, (bf16_t*)(ws + WS_WDN + l * SZ_WDN), DFF, 1024, [=](int k, int n) { return w[(size_t)k * 1024 + n]; }); }
    }
    { const float* w = p->in[11]; bf16_t* d = (bf16_t*)(ws + WS_WSG);
      for (size_t i = (size_t)cx.bx * NTHREADS + cx.tid; i < (size_t)NL * 8 * 128 * 128; i += (size_t)cx.gd * NTHREADS) d[i] = (bf16_t)f2bf(w[i]); }
}

__device__ __forceinline__ void phase_rmsnorm(const Ctx cx, const float* __restrict__ x, const float* __restrict__ g, bf16_t* __restrict__ h, int rows) {
    const int wv = cx.tid >> 6, lane = cx.tid & 63;
    constexpr int NR = 8;
    f32x4 g4[4];
#pragma unroll
    for (int i = 0; i < 4; ++i) g4[i] = *(const f32x4*)(g + i * 256 + lane * 4);
    for (int r0 = (cx.bx * 8 + wv) * NR; r0 < rows; r0 += cx.gd * 8 * NR) {
        f32x4 v[NR][4];
#pragma unroll
        for (int k = 0; k < NR; ++k)
#pragma unroll
            for (int i = 0; i < 4; ++i) v[k][i] = *(const f32x4*)(x + (size_t)(r0 + k) * 1024 + i * 256 + lane * 4);
#pragma unroll
        for (int k = 0; k < NR; ++k) { float ss = 0.f;
#pragma unroll
            for (int i = 0; i < 4; ++i) ss += v[k][i][0] * v[k][i][0] + v[k][i][1] * v[k][i][1] + v[k][i][2] * v[k][i][2] + v[k][i][3] * v[k][i][3];
            ss = wsum(ss); const float rs = rsqrtf(ss * (1.0f / 1024.0f) + 1e-6f);
#pragma unroll
            for (int i = 0; i < 4; ++i) { u32x2 o; o[0] = pk2(v[k][i][0] * rs * g4[i][0], v[k][i][1] * rs * g4[i][1]); o[1] = pk2(v[k][i][2] * rs * g4[i][2], v[k][i][3] * rs * g4[i][3]);
                *(u32x2*)(h + (size_t)(r0 + k) * 1024 + i * 256 + lane * 4) = o; } }
    }
}
template <bool FINAL> __device__ __forceinline__ void phase_rmsnorm_bf(const Ctx cx, const bf16_t* __restrict__ xb, const float* __restrict__ g, bf16_t* __restrict__ h, float* __restrict__ out, int rows) {
    const int wv = cx.tid >> 6, lane = cx.tid & 63;
    constexpr int NR = 8;
    float gg[16];
#pragma unroll
    for (int i = 0; i < 2; ++i)
#pragma unroll
        for (int e = 0; e < 8; ++e) gg[i * 8 + e] = g[i * 512 + lane * 8 + e];
    for (int r0 = (cx.bx * 8 + wv) * NR; r0 < rows; r0 += cx.gd * 8 * NR) {
        u32x4 q[NR][2];
#pragma unroll
        for (int k = 0; k < NR; ++k)
#pragma unroll
            for (int i = 0; i < 2; ++i) q[k][i] = *(const u32x4*)(xb + (size_t)(r0 + k) * 1024 + i * 512 + lane * 8);
#pragma unroll
        for (int k = 0; k < NR; ++k) { float v[16]; float ss = 0.f;
#pragma unroll
            for (int i = 0; i < 2; ++i)
#pragma unroll
                for (int j = 0; j < 4; ++j) { v[i * 8 + 2 * j] = bflo(q[k][i][j]); v[i * 8 + 2 * j + 1] = bfhi(q[k][i][j]); ss += v[i * 8 + 2 * j] * v[i * 8 + 2 * j] + v[i * 8 + 2 * j + 1] * v[i * 8 + 2 * j + 1]; }
            ss = wsum(ss); const float rs = rsqrtf(ss * (1.0f / 1024.0f) + 1e-6f);
#pragma unroll
            for (int i = 0; i < 2; ++i) {
                if (FINAL) { float* op = out + (size_t)(r0 + k) * 1024 + i * 512 + lane * 8;
                    *(f32x4*)op = (f32x4){v[i * 8] * rs * gg[i * 8], v[i * 8 + 1] * rs * gg[i * 8 + 1], v[i * 8 + 2] * rs * gg[i * 8 + 2], v[i * 8 + 3] * rs * gg[i * 8 + 3]};
                    *(f32x4*)(op + 4) = (f32x4){v[i * 8 + 4] * rs * gg[i * 8 + 4], v[i * 8 + 5] * rs * gg[i * 8 + 5], v[i * 8 + 6] * rs * gg[i * 8 + 6], v[i * 8 + 7] * rs * gg[i * 8 + 7]}; }
                else { u32x4 o;
#pragma unroll
                    for (int j = 0; j < 4; ++j) o[j] = pk2(v[i * 8 + 2 * j] * rs * gg[i * 8 + 2 * j], v[i * 8 + 2 * j + 1] * rs * gg[i * 8 + 2 * j + 1]);
                    *(u32x4*)(h + (size_t)(r0 + k) * 1024 + i * 512 + lane * 8) = o; } } }
    }
}
__device__ __forceinline__ void phase_final_norm(const Ctx cx, float* x, const float* __restrict__ g, int rows) {
    const int wv = cx.tid >> 6, lane = cx.tid & 63;
    constexpr int NR = 4;
    f32x4 g4[4];
#pragma unroll
    for (int i = 0; i < 4; ++i) g4[i] = *(const f32x4*)(g + i * 256 + lane * 4);
    for (int r0 = (cx.bx * 8 + wv) * NR; r0 < rows; r0 += cx.gd * 8 * NR) {
        f32x4 v[NR][4];
#pragma unroll
        for (int k = 0; k < NR; ++k)
#pragma unroll
            for (int i = 0; i < 4; ++i) v[k][i] = *(const f32x4*)(x + (size_t)(r0 + k) * 1024 + i * 256 + lane * 4);
#pragma unroll
        for (int k = 0; k < NR; ++k) { float ss = 0.f;
#pragma unroll
            for (int i = 0; i < 4; ++i) ss += v[k][i][0] * v[k][i][0] + v[k][i][1] * v[k][i][1] + v[k][i][2] * v[k][i][2] + v[k][i][3] * v[k][i][3];
            ss = wsum(ss); const float rs = rsqrtf(ss * (1.0f / 1024.0f) + 1e-6f);
#pragma unroll
            for (int i = 0; i < 4; ++i) *(f32x4*)(x + (size_t)(r0 + k) * 1024 + i * 256 + lane * 4) = v[k][i] * rs * g4[i]; }
    }
}

__device__ __forceinline__ void phase_prep(const Ctx cx, KP p, int l, int grp) {
    unsigned char* ws = p->ws;
    const bf16_t* P = (const bf16_t*)(ws + WS_P);
    bf16_t* CQN = (bf16_t*)(ws + WS_CQN); bf16_t* CKVN = (bf16_t*)(ws + WS_CKVN); bf16_t* KR = (bf16_t*)(ws + WS_KR); float* CS = (float*)(ws + WS_CS);
    bf16_t* RKV = (bf16_t*)(ws + WS_RKV); bf16_t* LIN = (bf16_t*)(ws + WS_LIN); float* KN = (float*)(ws + WS_KN);
    const int* positions = (const int*)p->in[1];
    const float* qg = p->in[5] + l * 384; const float* kvg = p->in[7] + l * 256;
    const float* mu = p->in[13] + l * 1920; const float* k_k = p->in[19] + l * 512;
    const int wv = cx.tid >> 6, lane = cx.tid & 63;
    const float inv_freq = 1.0f / powf(10000.0f, (float)(lane & 15) * (1.0f / 16.0f));
    for (int r = cx.bx * 8 + wv; r < TG; r += cx.gd * 8) {
        const bf16_t* pr = P + (size_t)r * NP;
        { float v[6]; float ss = 0.f;
#pragma unroll
          for (int i = 0; i < 3; ++i) { const unsigned w = *(const unsigned*)(pr + i * 128 + lane * 2); v[2 * i] = bflo(w); v[2 * i + 1] = bfhi(w); ss += v[2 * i] * v[2 * i] + v[2 * i + 1] * v[2 * i + 1]; }
          ss = wsum(ss); const float rs = rsqrtf(ss * (1.0f / 384.0f) + 1e-6f);
#pragma unroll
          for (int i = 0; i < 3; ++i) { const int c = i * 128 + lane * 2; *(unsigned*)(CQN + (size_t)r * 384 + c) = pk2(v[2 * i] * rs * qg[c], v[2 * i + 1] * rs * qg[c + 1]); } }
        { const u32x2 w = *(const u32x2*)(pr + 384 + lane * 4); float v[4] = {bflo(w[0]), bfhi(w[0]), bflo(w[1]), bfhi(w[1])};
          float ss = v[0] * v[0] + v[1] * v[1] + v[2] * v[2] + v[3] * v[3]; ss = wsum(ss); const float rs = rsqrtf(ss * (1.0f / 256.0f) + 1e-6f);
          const f32x4 g4 = *(const f32x4*)(kvg + lane * 4); u32x2 o; o[0] = pk2(v[0] * rs * g4[0], v[1] * rs * g4[1]); o[1] = pk2(v[2] * rs * g4[2], v[3] * rs * g4[3]);
          *(u32x2*)(CKVN + (size_t)r * 256 + lane * 4) = o; }
        if (lane < 16) {
          const float pos = (float)positions[(size_t)grp * TG + r];
          const float ang = pos * inv_freq; const float rev = __builtin_amdgcn_fractf(ang * 0.15915494309189535f);
          const float c = __builtin_amdgcn_cosf(rev), s = __builtin_amdgcn_sinf(rev);
          CS[(size_t)r * 32 + lane] = c; CS[(size_t)r * 32 + 16 + lane] = s; }
        { const bf16_t* pz = pr + OFF_RW; const int s = r & (SEQ - 1); const bool hasp = s > 0, hasn = s < SEQ - 1;
#pragma unroll
          for (int ig = 0; ig < 3; ++ig) {
              unsigned wz[5], wp[5], wn[5]; f32x2 m2[5];
#pragma unroll
              for (int j = 0; j < 5; ++j) { const int c = (ig * 5 + j) * 128 + lane * 2;
                  wz[j] = *(const unsigned*)(pz + c); wp[j] = hasp ? *(const unsigned*)(pz - NP + c) : 0u; wn[j] = hasn ? *(const unsigned*)(pz + NP + c) : 0u; m2[j] = *(const f32x2*)(mu + c); }
#pragma unroll
              for (int j = 0; j < 5; ++j) { const int i = ig * 5 + j;
                  const float z0 = bflo(wz[j]), z1 = bfhi(wz[j]);
                  const float y0 = z0 + m2[j][0] * (0.5f * (bflo(wp[j]) + bflo(wn[j])) - z0), y1 = z1 + m2[j][1] * (0.5f * (bfhi(wp[j]) + bfhi(wn[j])) - z1);
                  if (i < 12) { *(unsigned*)(RKV + ((size_t)r * 3 + (i >> 2)) * 512 + (i & 3) * 128 + lane * 2) = pk2(y0, y1);
                      if (i >= 4 && i < 8) { const int kc = (i - 4) * 128 + lane * 2; const float a = y0 * k_k[kc], b = y1 * k_k[kc + 1]; float ss = a * a + b * b;
                          ss = hsum32(ss);
                          const float inv = 1.0f / fmaxf(sqrtf(ss), 1e-12f); if ((lane & 31) == 0) KN[(size_t)r * 8 + (i - 4) * 2 + (lane >> 5)] = inv; } }
                  else if (i == 12) *(unsigned*)(LIN + (size_t)r * 384 + lane * 2) = pk2(tanhf_(y0), tanhf_(y1));
                  else if (i == 13) *(unsigned*)(LIN + (size_t)r * 384 + 128 + lane * 2) = pk2(y0, y1);
                  else *(unsigned*)(LIN + (size_t)r * 384 + 256 + lane * 2) = pk2(sigmoidf_(y0), sigmoidf_(y1)); } } }
    }
}

__device__ __forceinline__ void phase_sg(const Ctx cx, KP p, int l, unsigned char* smem) {
    unsigned char* ws = p->ws;
    const bf16_t* P = (const bf16_t*)(ws + WS_P); bf16_t* YB = (bf16_t*)(ws + WS_YB);
    const bf16_t* Wsg = (const bf16_t*)(ws + WS_WSG) + (size_t)l * 8 * 128 * 128;
    const float* lng = p->in[9] + l * 512; const float* lnb = p->in[10] + l * 512; const float* sgb = p->in[12] + l * 8 * 128;
    constexpr int VP = 520;
    bf16_t* vn = (bf16_t*)smem;
    const int tid = cx.tid, wv = tid >> 6, lane = tid & 63, l15 = lane & 15, g4 = lane >> 4;
    for (int it = cx.bx; it < TG / 128; it += cx.gd) {
        const int r0 = it * 128;
        __syncthreads();
        f32x4 ga = *(const f32x4*)(lng + lane * 8), gb = *(const f32x4*)(lng + lane * 8 + 4), ba = *(const f32x4*)(lnb + lane * 8), bb = *(const f32x4*)(lnb + lane * 8 + 4);
        for (int tb = 0; tb < 16; tb += 4) { u32x4 raw4[4];
#pragma unroll
          for (int q = 0; q < 4; ++q) raw4[q] = *(const u32x4*)(P + (size_t)(r0 + wv * 16 + tb + q) * NP + OFF_SG + 512 + lane * 8);
#pragma unroll
          for (int q = 0; q < 4; ++q) { const int t = wv * 16 + tb + q; const u32x4 raw = raw4[q];
            float x[8]; float sm = 0.f;
#pragma unroll
            for (int j = 0; j < 4; ++j) { x[2 * j] = gelu_tanh(bflo(raw[j])); x[2 * j + 1] = gelu_tanh(bfhi(raw[j])); sm += x[2 * j] + x[2 * j + 1]; }
            const float mean = wsum(sm) * (1.0f / 512.0f); float sq = 0.f;
#pragma unroll
            for (int j = 0; j < 8; ++j) { x[j] -= mean; sq += x[j] * x[j]; }
            const float rs = rsqrtf(wsum(sq) * (1.0f / 512.0f) + 1e-5f);
            u32x4 o; o[0] = pk2(x[0] * rs * ga[0] + ba[0], x[1] * rs * ga[1] + ba[1]); o[1] = pk2(x[2] * rs * ga[2] + ba[2], x[3] * rs * ga[3] + ba[3]);
            o[2] = pk2(x[4] * rs * gb[0] + bb[0], x[5] * rs * gb[1] + bb[1]); o[3] = pk2(x[6] * rs * gb[2] + bb[2], x[7] * rs * gb[3] + bb[3]);
            *(u32x4*)(vn + t * VP + lane * 8) = o; } }
        __syncthreads();
        const int gi = wv;
        for (int half = 0; half < 2; ++half) {
            f32x4 acc[4][4];
#pragma unroll
            for (int a = 0; a < 4; ++a)
#pragma unroll
                for (int b = 0; b < 4; ++b) acc[a][b] = (f32x4){0.f, 0.f, 0.f, 0.f};
#pragma unroll 1
            for (int ks = 0; ks < 4; ++ks) {
                bf16x8 af[4];
#pragma unroll
                for (int dt = 0; dt < 4; ++dt)
#pragma unroll
                    for (int j = 0; j < 8; ++j) af[dt][j] = (short)vn[(ks * 32 + g4 * 8 + j) * VP + gi * 64 + dt * 16 + l15];
#pragma unroll
                for (int mt = 0; mt < 4; ++mt) {
                    const bf16x8 bfr = *(const bf16x8*)(Wsg + ((size_t)gi * 128 + (half * 4 + mt) * 16 + l15) * 128 + ks * 32 + g4 * 8);
#pragma unroll
                    for (int dt = 0; dt < 4; ++dt) acc[mt][dt] = __builtin_amdgcn_mfma_f32_16x16x32_bf16(af[dt], bfr, acc[mt][dt], 0, 0, 0);
                }
            }
#pragma unroll
            for (int mt = 0; mt < 4; ++mt) { const int t = (half * 4 + mt) * 16 + l15; const float bias = sgb[gi * 128 + t];
#pragma unroll
                for (int dt = 0; dt < 4; ++dt) { const int d0 = gi * 64 + dt * 16 + g4 * 4;
                    const u32x2 uq = *(const u32x2*)(P + (size_t)(r0 + t) * NP + OFF_SG + d0);
                    u32x2 o; o[0] = pk2(gelu_tanh(bflo(uq[0])) * (acc[mt][dt][0] + bias), gelu_tanh(bfhi(uq[0])) * (acc[mt][dt][1] + bias));
                    o[1] = pk2(gelu_tanh(bflo(uq[1])) * (acc[mt][dt][2] + bias), gelu_tanh(bfhi(uq[1])) * (acc[mt][dt][3] + bias));
                    *(u32x2*)(YB + (size_t)(r0 + t) * 512 + d0) = o; } }
        }
    }
}

__device__ __forceinline__ bf16x8 pack4z(float a, float b, float c, float d) { u32x4 t; t[0] = pk2(a, b); t[1] = pk2(c, d); t[2] = 0u; t[3] = 0u; return __builtin_bit_cast(bf16x8, t); }
__device__ __forceinline__ void phase_scan(const Ctx cx, KP p, int l, unsigned char* smem) {
    unsigned char* ws = p->ws;
    const bf16_t* __restrict__ RKV = (const bf16_t*)(ws + WS_RKV); const bf16_t* __restrict__ LOUT = (const bf16_t*)(ws + WS_LOUT); const float* __restrict__ KN = (const float*)(ws + WS_KN);
    bf16_t* __restrict__ YD = (bf16_t*)(ws + WS_YD);
    constexpr int KP2 = 72, VP2 = 24, SP2 = 72, CH = 16, NCH = SEQ / CH;
    constexpr int OPB_BYTES = 256 + 4 * 16 * KP2 * 2 + 3 * 64 * VP2 * 2;
    float* wl = (float*)smem;
    float* ybuf = wl + 1024;
    unsigned char* opb0 = smem + 8192;
    bf16_t* Sc = (bf16_t*)(opb0 + 2 * OPB_BYTES);
    const int tid = cx.tid, wv = tid >> 6, lane = tid & 63, l15 = lane & 15, g4 = lane >> 4;
    const bool is_prep = wv >= 4;
    const int j = lane, tq4 = wv - 4, it = wv;
    const int je = j & ~1; const bool jodd = (j & 1) != 0;
    const unsigned jsh = jodd ? 0u : 16u;
#define BSEL(W) __uint_as_float(((W) << jsh) & 0xffff0000u)
    for (int ci = cx.bx; ci < 2 * GBATCH * 8; ci += cx.gd) {
        const int dir = ci >> 7, bl = (ci >> 3) & 15, hh = ci & 7;
        const float kkw = (p->in[19] + l * 512)[hh * 64 + j], kaw = (p->in[20] + l * 512)[hh * 64 + j];
        __syncthreads();
        for (int idx = tid; idx < 64 * SP2 / 2; idx += NTHREADS) ((unsigned*)Sc)[idx] = 0u;
        f32x4 stS[4];
#pragma unroll
        for (int q = 0; q < 4; ++q) stS[q] = (f32x4){0.f, 0.f, 0.f, 0.f};
        unsigned xr[4], xk[4], xv[4], xu[4], xa[4]; float xn[4];
        float w_[4], kk_[4], kd_[4], bb_[4], r_[4]; unsigned vraw_[4];
#define SCAN_FETCH(C) { _Pragma("unroll") for (int e = 0; e < 4; ++e) { const int stp = (C) * CH + 4 * tq4 + e; const size_t tok = (size_t)bl * SEQ + (dir ? (SEQ - 1 - stp) : stp); \
            xr[e] = *(const unsigned*)(RKV + (tok * 3 + 0) * 512 + hh * 64 + je); xk[e] = *(const unsigned*)(RKV + (tok * 3 + 1) * 512 + hh * 64 + je); xv[e] = *(const unsigned*)(RKV + (tok * 3 + 2) * 512 + hh * 64 + je); \
            xu[e] = *(const unsigned*)(LOUT + tok * 2560 + dir * 512 + hh * 64 + je); xa[e] = *(const unsigned*)(LOUT + tok * 2560 + 1024 + dir * 512 + hh * 64 + je); xn[e] = KN[tok * 8 + hh]; } }
#define SCAN_DECODE() { _Pragma("unroll") for (int e = 0; e < 4; ++e) { const float kf = BSEL(xk[e]), af = BSEL(xa[e]); w_[e] = 1.0f - BSEL(xu[e]); kk_[e] = kf * kkw * xn[e]; kd_[e] = kf * (1.0f + (af - 1.0f) * kaw); bb_[e] = kk_[e] * af; \
            r_[e] = BSEL(xr[e]); vraw_[e] = (xv[e] << jsh) >> 16; } \
            wl[tq4 * 64 + j] = (w_[0] * w_[1]) * (w_[2] * w_[3]); }
#define SCAN_OPERANDS(BUF) { unsigned char* ob_ = opb0 + (BUF) * OPB_BYTES; float* pc_ = (float*)ob_; bf16_t* KKT_ = (bf16_t*)(ob_ + 256); bf16_t* RT_ = KKT_ + 16 * KP2; bf16_t* KDI_ = RT_ + 16 * KP2; bf16_t* BBI_ = KDI_ + 16 * KP2; \
            bf16_t* KDCT_ = BBI_ + 16 * KP2; bf16_t* NBBCT_ = KDCT_ + 64 * VP2; bf16_t* Vs_ = NBBCT_ + 64 * VP2; \
            float gp_[4]; \
            _Pragma("unroll") for (int gq = 0; gq < 4; ++gq) gp_[gq] = wl[gq * 64 + j]; \
            const float g01_ = gp_[0] * gp_[1]; const float pr = g01_ * (gp_[2] * gp_[3]); \
            const float pa = tq4 == 0 ? 1.0f : (tq4 == 1 ? gp_[0] : (tq4 == 2 ? g01_ : g01_ * gp_[2])); \
            float pprev = pa; \
            _Pragma("unroll") for (int e = 0; e < 4; ++e) { const int t = 4 * tq4 + e; const float ptv = pprev * w_[e]; const float ip = __builtin_amdgcn_rcpf(ptv); const float kdi = kd_[e] * ip, bbi = bb_[e] * ip; \
                const unsigned c1_ = pk2(kk_[e] * pprev, r_[e] * ptv), c2_ = pk2(kdi, bbi), c3_ = pk2(kdi * pr, -bbi * pr); \
                KKT_[t * KP2 + j] = (bf16_t)(c1_ & 0xffffu); RT_[t * KP2 + j] = (bf16_t)(c1_ >> 16); KDI_[t * KP2 + j] = (bf16_t)(c2_ & 0xffffu); BBI_[t * KP2 + j] = (bf16_t)(c2_ >> 16); \
                KDCT_[j * VP2 + t] = (bf16_t)(c3_ & 0xffffu); NBBCT_[j * VP2 + t] = (bf16_t)(c3_ >> 16); Vs_[j * VP2 + t] = (bf16_t)vraw_[e]; pprev = ptv; } \
            if (tq4 == 0) pc_[j] = pr; }
        if (is_prep) { SCAN_FETCH(0) SCAN_DECODE() }
        lds_barrier();
        if (is_prep) { SCAN_FETCH(1) SCAN_OPERANDS(0) }
        lds_barrier();
#pragma unroll 1
        for (int c = 0; c < NCH; ++c) {
            if (is_prep) {
                if (c + 1 < NCH) { SCAN_DECODE() }
                lds_barrier();
                if (c + 2 < NCH) { SCAN_FETCH(c + 2) }
                if (c + 1 < NCH) { SCAN_OPERANDS((c + 1) & 1) }
                lds_barrier();
                if (tid < 256 + 128) { const int t = (tid - 256) >> 3, ig = tid & 7; const int stp = c * CH + t; const size_t tok = (size_t)bl * SEQ + (dir ? (SEQ - 1 - stp) : stp);
                    const f32x4 y0 = *(const f32x4*)(ybuf + t * 64 + ig * 8), y1 = *(const f32x4*)(ybuf + t * 64 + ig * 8 + 4);
                    u32x4 o; o[0] = pk2(y0[0], y0[1]); o[1] = pk2(y0[2], y0[3]); o[2] = pk2(y1[0], y1[1]); o[3] = pk2(y1[2], y1[3]);
                    *(u32x4*)(YD + ((size_t)dir * TG + tok) * 512 + hh * 64 + ig * 8) = o; }
            } else {
                const unsigned char* ob = opb0 + (c & 1) * OPB_BYTES; const float* pc = (const float*)ob; const bf16_t* KKT = (const bf16_t*)(ob + 256); const bf16_t* RT = KKT + 16 * KP2;
                const bf16_t* KDI = RT + 16 * KP2; const bf16_t* BBI = KDI + 16 * KP2; const bf16_t* KDCT = BBI + 16 * KP2; const bf16_t* NBBCT = KDCT + 64 * VP2; const bf16_t* Vs = NBBCT + 64 * VP2;
                f32x4 M1 = (f32x4){0.f, 0.f, 0.f, 0.f}, M2 = M1, N1 = M1, N2 = M1, XK = M1, XR = M1, M2T = M1;
#pragma unroll
                for (int ks = 0; ks < 2; ++ks) { const int off = l15 * KP2 + ks * 32 + g4 * 8;
                    const bf16x8 kdif = *(const bf16x8*)(KDI + off), bbif = *(const bf16x8*)(BBI + off), kktf = *(const bf16x8*)(KKT + off), rtf = *(const bf16x8*)(RT + off);
                    const bf16x8 sf = *(const bf16x8*)(Sc + (16 * it + l15) * SP2 + ks * 32 + g4 * 8);
                    M1 = __builtin_amdgcn_mfma_f32_16x16x32_bf16(kdif, kktf, M1, 0, 0, 0); M2 = __builtin_amdgcn_mfma_f32_16x16x32_bf16(bbif, kktf, M2, 0, 0, 0);
                    M2T = __builtin_amdgcn_mfma_f32_16x16x32_bf16(kktf, bbif, M2T, 0, 0, 0);
                    N1 = __builtin_amdgcn_mfma_f32_16x16x32_bf16(kdif, rtf, N1, 0, 0, 0); N2 = __builtin_amdgcn_mfma_f32_16x16x32_bf16(bbif, rtf, N2, 0, 0, 0);
                    XK = __builtin_amdgcn_mfma_f32_16x16x32_bf16(kktf, sf, XK, 0, 0, 0); XR = __builtin_amdgcn_mfma_f32_16x16x32_bf16(rtf, sf, XR, 0, 0, 0); }
                const u32x2 vq = *(const u32x2*)(Vs + (16 * it + l15) * VP2 + 4 * g4);
                u32x2 kaq[4], kbq[4]; f32x4 pcv[4];
#pragma unroll
                for (int q = 0; q < 4; ++q) { const int jrow = 16 * q + l15; kaq[q] = *(const u32x2*)(KDCT + jrow * VP2 + 4 * g4); kbq[q] = *(const u32x2*)(NBBCT + jrow * VP2 + 4 * g4); pcv[q] = *(const f32x4*)(pc + 16 * q + 4 * g4); }
                lds_barrier();
#pragma unroll
                for (int r = 0; r < 4; ++r) { const int s = 4 * g4 + r; if (!(s < l15)) { M1[r] = 0.f; M2[r] = 0.f; } if (!(s <= l15)) { N1[r] = 0.f; N2[r] = 0.f; } if (!(l15 < s)) M2T[r] = 0.f; }
                const f32x4 Z4 = (f32x4){0.f, 0.f, 0.f, 0.f};
                f32x4 Id;
#pragma unroll
                for (int r = 0; r < 4; ++r) Id[r] = (4 * g4 + r == l15) ? 1.0f : 0.0f;
#define PK4(X) pack4z((X)[0], (X)[1], (X)[2], (X)[3])
#define MM(A_, B_) __builtin_amdgcn_mfma_f32_16x16x32_bf16(PK4(A_), PK4(B_), Z4, 0, 0, 0)
                const f32x4 P2 = MM(M2T, M2), P2T = MM(M2, M2T);
                const f32x4 P4 = MM(P2T, P2), P4T = MM(P2, P2T);
                const f32x4 P8 = MM(P4T, P4);
                const f32x4 a1 = Id + P4T, b1w = Id + P8, a2 = Id + P2, b2u = Id - M2T;
                const f32x4 Wm = MM(a1, b1w);
                const f32x4 UT = MM(a2, b2u);
                const f32x4 Tm = MM(UT, Wm);
#undef MM
                const bf16x8 AT = PK4(Tm);
                u32x4 b1; b1[0] = vq[0]; b1[1] = vq[1]; b1[2] = 0u; b1[3] = 0u;
                const f32x4 W1 = __builtin_amdgcn_mfma_f32_16x16x32_bf16(PK4(M1), __builtin_bit_cast(bf16x8, b1), XK, 0, 0, 0);
                const f32x4 SA = __builtin_amdgcn_mfma_f32_16x16x32_bf16(AT, PK4(W1), Z4, 0, 0, 0);
#undef PK4
                u32x4 bfq; bfq[0] = vq[0]; bfq[1] = vq[1]; bfq[2] = pk2(SA[0], SA[1]); bfq[3] = pk2(SA[2], SA[3]);
                const bf16x8 Bf = __builtin_bit_cast(bf16x8, bfq);
                { u32x4 a3; a3[0] = pk2(N1[0], N1[1]); a3[1] = pk2(N1[2], N1[3]); a3[2] = pk2(-N2[0], -N2[1]); a3[3] = pk2(-N2[2], -N2[3]);
                  const f32x4 Y = __builtin_amdgcn_mfma_f32_16x16x32_bf16(__builtin_bit_cast(bf16x8, a3), Bf, XR, 0, 0, 0);
#pragma unroll
                  for (int r = 0; r < 4; ++r) ybuf[(4 * g4 + r) * 64 + 16 * it + l15] = Y[r]; }
#pragma unroll
                for (int q = 0; q < 4; ++q) {
                    u32x4 a4; a4[0] = kaq[q][0]; a4[1] = kaq[q][1]; a4[2] = kbq[q][0]; a4[3] = kbq[q][1];
                    stS[q] = __builtin_amdgcn_mfma_f32_16x16x32_bf16(__builtin_bit_cast(bf16x8, a4), Bf, stS[q] * pcv[q], 0, 0, 0);
                    u32x2 sw; sw[0] = pk2(stS[q][0], stS[q][1]); sw[1] = pk2(stS[q][2], stS[q][3]);
                    *(u32x2*)(Sc + (16 * it + l15) * SP2 + 16 * q + 4 * g4) = sw; }
                lds_barrier();
            }
        }
#undef SCAN_FETCH
#undef SCAN_DECODE
#undef SCAN_OPERANDS
    }
#undef BSEL
}

__device__ __forceinline__ void phase_rwpost(const Ctx cx, KP p, int l) {
    unsigned char* ws = p->ws;
    const bf16_t* __restrict__ RKV = (const bf16_t*)(ws + WS_RKV); const bf16_t* __restrict__ LOUT = (const bf16_t*)(ws + WS_LOUT); const bf16_t* __restrict__ YD = (const bf16_t*)(ws + WS_YD);
    bf16_t* __restrict__ YC = (bf16_t*)(ws + WS_YC);
    const int wv = cx.tid >> 6, lane = cx.tid & 63; const int ch = lane * 8;
    float ka[8], rk[8], lg[8], lb[8];
#pragma unroll
    for (int e = 0; e < 8; ++e) { ka[e] = (p->in[20] + l * 512)[ch + e]; rk[e] = (p->in[21] + l * 512)[ch + e]; lg[e] = (p->in[22] + l * 512)[ch + e]; lb[e] = (p->in[23] + l * 512)[ch + e]; }
    for (int r = cx.bx * 8 + wv; r < TG; r += cx.gd * 8) {
        const u32x4 q0 = *(const u32x4*)(YD + (size_t)r * 512 + ch), q1 = *(const u32x4*)(YD + ((size_t)TG + r) * 512 + ch);
        const u32x4 qr = *(const u32x4*)(RKV + ((size_t)r * 3 + 0) * 512 + ch), qk = *(const u32x4*)(RKV + ((size_t)r * 3 + 1) * 512 + ch), qv = *(const u32x4*)(RKV + ((size_t)r * 3 + 2) * 512 + ch);
        const u32x4 qa0 = *(const u32x4*)(LOUT + (size_t)r * 2560 + 1024 + ch), qa1 = *(const u32x4*)(LOUT + (size_t)r * 2560 + 1536 + ch), qg = *(const u32x4*)(LOUT + (size_t)r * 2560 + 2048 + ch);
        float y[8], bt = 0.f, sm = 0.f;
#pragma unroll
        for (int j = 0; j < 4; ++j) { y[2 * j] = bflo(q0[j]) + bflo(q1[j]); y[2 * j + 1] = bfhi(q0[j]) + bfhi(q1[j]); sm += y[2 * j] + y[2 * j + 1];
            bt += bflo(qr[j]) * bflo(qk[j]) * rk[2 * j] * (2.0f + (bflo(qa0[j]) + bflo(qa1[j]) - 2.0f) * ka[2 * j]);
            bt += bfhi(qr[j]) * bfhi(qk[j]) * rk[2 * j + 1] * (2.0f + (bfhi(qa0[j]) + bfhi(qa1[j]) - 2.0f) * ka[2 * j + 1]); }
        const float mean = red8(sm) * (1.0f / 64.0f); float sq = 0.f;
#pragma unroll
        for (int e = 0; e < 8; ++e) { y[e] -= mean; sq += y[e] * y[e]; }
        const float rs = rsqrtf(red8(sq) * (1.0f / 64.0f) + 64e-5f); const float bonus = red8(bt);
        u32x4 o;
#pragma unroll
        for (int j = 0; j < 4; ++j) o[j] = pk2((y[2 * j] * rs * lg[2 * j] + lb[2 * j] + bonus * bflo(qv[j])) * bflo(qg[j]), (y[2 * j + 1] * rs * lg[2 * j + 1] + lb[2 * j + 1] + bonus * bfhi(qv[j])) * bfhi(qg[j]));
        *(u32x4*)(YC + (size_t)r * 512 + ch) = o;
    }
}

__device__ __forceinline__ void phase_attn(const Ctx cx, KP p, unsigned char* smem) {
    unsigned char* ws = p->ws;
    const bf16_t* __restrict__ Q = (const bf16_t*)(ws + WS_Q); const bf16_t* __restrict__ KV = (const bf16_t*)(ws + WS_KV); const bf16_t* __restrict__ KR = (const bf16_t*)(ws + WS_KR); bf16_t* __restrict__ YA = (bf16_t*)(ws + WS_YA);
    constexpr int KP_ = 104, VTP = 72, BUFE = 64 * KP_ + 64 * VTP;
    bf16_t* lb = (bf16_t*)smem;
    const int tid = cx.tid, wv = tid >> 6, lane = tid & 63, l15 = lane & 15, g4 = lane >> 4;
    const int skey = tid >> 3, sch = tid & 7, skey2 = (tid & 255) >> 2, sch2 = tid & 3;
    const int vcol = skey ^ (sch << 3);
    for (int item0 = cx.bx; item0 < GBATCH * 8 * 8; item0 += cx.gd) {
        int item = item0;
        if (cx.gd == 256) { const int x = cx.bx & 7, li = (cx.bx >> 3) + 32 * (item0 >> 8); item = (((li >> 3) * 8 + x) << 3) | (li & 7); }
        const int qb = item & 7, hh = (item >> 3) & 7, bl = item >> 6;
        const size_t rb = (size_t)bl * SEQ; const size_t q0 = rb + qb * 256 + wv * 32;
        bf16x8 qf[2][3];
#pragma unroll
        for (int qt = 0; qt < 2; ++qt)
#pragma unroll
            for (int ks = 0; ks < 3; ++ks) qf[qt][ks] = *(const bf16x8*)(Q + (q0 + qt * 16 + l15) * 768 + hh * 96 + ks * 32 + g4 * 8);
        f32x4 o[2][4], osum[2]; float mrun[2] = {-1e30f, -1e30f};
        osum[0] = (f32x4){0.f, 0.f, 0.f, 0.f}; osum[1] = osum[0];
#pragma unroll
        for (int a = 0; a < 2; ++a)
#pragma unroll
            for (int b = 0; b < 4; ++b) o[a][b] = (f32x4){0.f, 0.f, 0.f, 0.f};
        u32x4 gk = *(const u32x4*)(KV + (rb + skey) * 1024 + hh * 128 + sch * 8);
        u32x4 gv = *(const u32x4*)(KV + (rb + skey) * 1024 + hh * 128 + 64 + sch * 8);
        u32x4 gr = *(const u32x4*)(KR + (rb + skey2) * 32 + sch2 * 8);
        __syncthreads();
#define ATT_STAGE(BUF) { bf16_t* Ks_ = lb + (BUF) * BUFE; bf16_t* Vt_ = Ks_ + 64 * KP_; \
            *(u32x4*)(Ks_ + skey * KP_ + sch * 8) = gk; if (tid < 256) *(u32x4*)(Ks_ + skey2 * KP_ + 64 + sch2 * 8) = gr; \
            _Pragma("unroll") for (int j = 0; j < 4; ++j) { Vt_[(sch * 8 + 2 * j) * VTP + vcol] = (bf16_t)(gv[j] & 0xffffu); Vt_[(sch * 8 + 2 * j + 1) * VTP + vcol] = (bf16_t)(gv[j] >> 16); } }
#define ATT_FETCH(KT) { const size_t kb = rb + (size_t)(KT) * 64; \
            gk = *(const u32x4*)(KV + (kb + skey) * 1024 + hh * 128 + sch * 8); gv = *(const u32x4*)(KV + (kb + skey) * 1024 + hh * 128 + 64 + sch * 8); \
            gr = *(const u32x4*)(KR + (kb + skey2) * 32 + sch2 * 8); }
        ATT_STAGE(0)
        ATT_FETCH(1)
        __syncthreads();
        for (int kt = 0; kt < SEQ / 64; ++kt) {
            if (kt + 1 < SEQ / 64) { ATT_STAGE((kt + 1) & 1) }
            if (kt + 2 < SEQ / 64) { ATT_FETCH(kt + 2) }
            const bf16_t* Ks = lb + (kt & 1) * BUFE; const bf16_t* Vt = Ks + 64 * KP_;
            f32x4 s[2][4];
#pragma unroll
            for (int a = 0; a < 2; ++a)
#pragma unroll
                for (int b = 0; b < 4; ++b) s[a][b] = (f32x4){0.f, 0.f, 0.f, 0.f};
#pragma unroll
            for (int k4 = 0; k4 < 4; ++k4)
#pragma unroll
                for (int ks = 0; ks < 3; ++ks) { const bf16x8 kf = *(const bf16x8*)(Ks + (k4 * 16 + l15) * KP_ + ks * 32 + g4 * 8);
#pragma unroll
                    for (int qt = 0; qt < 2; ++qt) s[qt][k4] = __builtin_amdgcn_mfma_f32_16x16x32_bf16(kf, qf[qt][ks], s[qt][k4], 0, 0, 0); }
            bf16x8 pf[2][2];
#pragma unroll
            for (int qt = 0; qt < 2; ++qt) {
                float mx = s[qt][0][0];
#pragma unroll
                for (int k4 = 0; k4 < 4; ++k4)
#pragma unroll
                    for (int j = 0; j < 4; ++j) mx = fmaxf(mx, s[qt][k4][j]);
                mx = max_swap32(max_swap16(mx));
                const float mn = fmaxf(mrun[qt], mx); const float al = __builtin_amdgcn_exp2f(mrun[qt] - mn); mrun[qt] = mn;
                unsigned pw[8];
#pragma unroll
                for (int k4 = 0; k4 < 4; ++k4) { float e[4];
#pragma unroll
                    for (int j = 0; j < 4; ++j) e[j] = __builtin_amdgcn_exp2f(s[qt][k4][j] - mn);
                    pw[k4 * 2] = pk2(e[0], e[1]); pw[k4 * 2 + 1] = pk2(e[2], e[3]); }
                if (__builtin_amdgcn_ballot_w64(al != 1.0f) != 0ull) {
#pragma unroll
                    for (int dt = 0; dt < 4; ++dt) o[qt][dt] *= al;
                    osum[qt] *= al; }
#pragma unroll
                for (int ks2 = 0; ks2 < 2; ++ks2) { u32x4 t; t[0] = pw[ks2 * 4]; t[1] = pw[ks2 * 4 + 1]; t[2] = pw[ks2 * 4 + 2]; t[3] = pw[ks2 * 4 + 3]; pf[qt][ks2] = __builtin_bit_cast(bf16x8, t); }
            }
            { u32x4 t1; const unsigned one2 = (l15 == 0) ? 0x3F803F80u : 0u; t1[0] = one2; t1[1] = one2; t1[2] = one2; t1[3] = one2; const bf16x8 vones = __builtin_bit_cast(bf16x8, t1);
#pragma unroll
              for (int ks2 = 0; ks2 < 2; ++ks2)
#pragma unroll
                  for (int qt = 0; qt < 2; ++qt) osum[qt] = __builtin_amdgcn_mfma_f32_16x16x32_bf16(vones, pf[qt][ks2], osum[qt], 0, 0, 0); }
#pragma unroll
            for (int dt = 0; dt < 4; ++dt) { const int vrow = (dt * 16 + l15) * VTP, vsw = (dt * 2 + (l15 >> 3)) << 3;
#pragma unroll
                for (int ks2 = 0; ks2 < 2; ++ks2) {
                    const u32x2 lo = *(const u32x2*)(Vt + vrow + (((2 * ks2) * 16 + g4 * 4) ^ vsw)), hi = *(const u32x2*)(Vt + vrow + (((2 * ks2 + 1) * 16 + g4 * 4) ^ vsw));
                    u32x4 t; t[0] = lo[0]; t[1] = lo[1]; t[2] = hi[0]; t[3] = hi[1]; const bf16x8 vf = __builtin_bit_cast(bf16x8, t);
#pragma unroll
                    for (int qt = 0; qt < 2; ++qt) o[qt][dt] = __builtin_amdgcn_mfma_f32_16x16x32_bf16(vf, pf[qt][ks2], o[qt][dt], 0, 0, 0); } }
            lds_barrier();
        }
#undef ATT_STAGE
#undef ATT_FETCH
#pragma unroll
        for (int qt = 0; qt < 2; ++qt) { const float lt = __shfl(osum[qt][0], l15); const float inv = 1.0f / lt;
#pragma unroll
            for (int dt = 0; dt < 4; ++dt) { u32x2 w; w[0] = pk2(o[qt][dt][0] * inv, o[qt][dt][1] * inv); w[1] = pk2(o[qt][dt][2] * inv, o[qt][dt][3] * inv);
                *(u32x2*)(YA + (q0 + qt * 16 + l15) * 512 + hh * 64 + dt * 16 + g4 * 4) = w; } }
    }
}

constexpr int NS = 19;
constexpr int N_PHASES = 1 + NL * NGRP * NS;
__device__ __forceinline__ bool stage_needs_sync(int st) { return !(st == 2 || st == 4 || st == 5 || st == 7 || st == 9 || st == 11 || st == 12); }

__global__ void __launch_bounds__(NTHREADS, 2) mega(Params pdummy) {
    extern __shared__ __attribute__((aligned(16))) unsigned char smem[];
    cg::grid_group grid = cg::this_grid();
    LAS unsigned char* lds = (LAS unsigned char*)smem;
    int ph_lo, ph_hi; XcdBarrier xbar;
    { KP p0 = get_kp(); ph_lo = p0->ph_lo; ph_hi = p0->ph_hi;
      volatile LAS unsigned* stw = (volatile LAS unsigned*)(lds + LDS_MAIN);
      if (threadIdx.x == 0) { stw[0] = 0u; stw[1] = 0u; }
      __syncthreads();
      xbar.bar = (unsigned*)(p0->ws + WS_BAR); xbar.x = xb_xcc_id(); xbar.st = stw;
      if (threadIdx.x == 0) (void)xb_add(&xbar.bar[XB_XCNT(xbar.x)], 1u); }
    bool repeated = false;
#pragma unroll 1
    for (int ph = ph_lo; ph < ph_hi;) {
        bool need_sync = true, again = false;
        Ctx cx; cx.tid = (int)threadIdx.x; cx.bx = (int)blockIdx.x; cx.gd = (int)gridDim.x; asm volatile("" : "+v"(cx.tid), "+s"(cx.bx), "+s"(cx.gd));
        const int G = cx.gd, bx = cx.bx;
        if (ph == 0) { KP p = get_kp(); phase_convert(cx, p, smem); }
        else {
            const int q = ph - 1; const int grp = q / (NL * NS), l = (q / NS) % NL, st = q % NS;
            need_sync = stage_needs_sync(st) && !(st == 18 && l != NL - 1);
            const size_t xoff = (size_t)grp * TG * 1024;
#define GETP KP p = get_kp(); unsigned char* ws = p->ws; (void)ws;
            if (REPEAT_MASK != 0 && ((REPEAT_MASK >> st) & 1) && !repeated) again = true;
            int ste = st; if ((st == 9 || st == 10) && ((bx >> 3) & 1)) ste = 19 - st;
            if ((st == 7 || st == 8) && ((bx >> 3) & 1)) ste = 15 - st;
            switch (ste) {
            case 0: { GETP
                if (l == 0) phase_rmsnorm(cx, p->in[0] + xoff, p->in[2] + l * 1024, (bf16_t*)(ws + WS_H), TG);
                else phase_rmsnorm_bf<false>(cx, (const bf16_t*)(ws + WS_XB), p->in[2] + l * 1024, (bf16_t*)(ws + WS_H), nullptr, TG); } break;
            case 1: { GETP
                pg8::Gemm g{(const bf16_t*)(ws + WS_H), (const bf16_t*)(ws + WS_WIN + l * SZ_WIN), TG, NPP, 1024, 1024}; pg8::StaticOrder S; S.init(TG, NPP, G, bx);
                pg8::EpiStore E{(bf16_t*)(ws + WS_P), NP, NP}; pg8::gemm_phase(cx, lds, g, S, E); } break;
            case 2: { GETP phase_prep(cx, p, l, grp); } break;
            case 3: { GETP phase_sg(cx, p, l, smem); } break;
            case 4: { GETP
                pg8::Gemm g{(const bf16_t*)(ws + WS_CQN), (const bf16_t*)(ws + WS_WUQ + l * SZ_WUQ), TG, 768, 384, 384}; pg8::StaticOrder S; S.init(TG, 768, G, bx);
                pg8::EpiQ E{(bf16_t*)(ws + WS_Q), (const float*)(ws + WS_CS)}; pg8::gemm_phase(cx, lds, g, S, E); } break;
            case 5: { GETP
                pg8::Gemm g{(const bf16_t*)(ws + WS_CKVN), (const bf16_t*)(ws + WS_WUKV + l * SZ_WUKV), TG, 1024, 256, 256}; pg8::StaticOrder S; S.init(TG, 1024, G, bx);
                pg8::EpiStore E{(bf16_t*)(ws + WS_KV), 1024, 1024}; pg8::gemm_phase(cx, lds, g, S, E);
                { pg8::Gemm g2{(const bf16_t*)(ws + WS_H), (const bf16_t*)(ws + WS_WKR + l * SZ_WKR), TG, 256, 1024, 1024}; pg8::StaticOrder S2; S2.init(TG, 256, G, (bx + G / 2) % G);
                  pg8::EpiKR E2{(bf16_t*)(ws + WS_KR), (const float*)(ws + WS_CS)}; pg8::gemm_phase(cx, lds, g2, S2, E2); } } break;
            case 6: { GETP
                { pg8::Gemm g{(const bf16_t*)(ws + WS_LIN), (const bf16_t*)(ws + WS_WLORA + l * SZ_WLORA), TG, 2048, 256, 384}; pg8::StaticOrder S; S.init(TG, 2048, G, bx);
                  pg8::EpiLora E{(bf16_t*)(ws + WS_LOUT), p->in[14] + l * 1024, p->in[16] + l * 1024, 0}; pg8::gemm_phase(cx, lds, g, S, E); }
                { pg8::Gemm g{(const bf16_t*)(ws + WS_LIN) + 128, (const bf16_t*)(ws + WS_WLORA + l * SZ_WLORA) + (size_t)2048 * 256, TG, 512, 256, 384}; pg8::StaticOrder S; S.init(TG, 512, G, bx);
                  pg8::EpiLora E{(bf16_t*)(ws + WS_LOUT), p->in[14] + l * 1024, p->in[16] + l * 1024, 2048}; pg8::gemm_phase(cx, lds, g, S, E); } } break;
            case 7: { GETP phase_scan(cx, p, l, smem); } break;
            case 8: { GETP phase_attn(cx, p, smem); } break;
            case 9: { GETP phase_rwpost(cx, p, l); } break;
            case 10: { GETP
                pg8::Gemm g{(const bf16_t*)(ws + WS_H), (const bf16_t*)(ws + WS_WG + l * SZ_WG), TG, 3072, 1024, 1024}; pg8::StaticOrder S; S.init(TG, 3072, G, bx);
                pg8::EpiGate E{(bf16_t*)(ws + WS_P), p->in[4] + l * 3072}; pg8::gemm_phase(cx, lds, g, S, E); } break;
            case 11: case 12: case 13: { GETP
                const int nb = st - 11;
                pg8::Gemm g{(const bf16_t*)(ws + WS_YA) + (size_t)nb * TG * 512, (const bf16_t*)(ws + WS_WBR + l * SZ_WBR) + (size_t)nb * 1024 * 512, TG, 1024, 512, 512};
                pg8::StaticOrder S; S.init(TG, 1024, G, bx); pg8::EpiBranch E{(bf16_t*)(ws + WS_KV), (const bf16_t*)(ws + WS_P), nb}; pg8::gemm_phase(cx, lds, g, S, E); } break;
            case 14: { GETP
                pg8::Gemm g{(const bf16_t*)(ws + WS_KV), (const bf16_t*)(ws + WS_WOUT + l * SZ_WOUT), TG, 1024, 1024, 1024}; pg8::StaticOrder S; S.init(TG, 1024, G, bx);
                if (l == 0) { pg8::EpiResidB<true> E{p->in[0] + xoff, nullptr, (bf16_t*)(ws + WS_XB)}; pg8::gemm_phase(cx, lds, g, S, E); }
                else { pg8::EpiResidB<false> E{nullptr, (const bf16_t*)(ws + WS_XB), (bf16_t*)(ws + WS_XB)}; pg8::gemm_phase(cx, lds, g, S, E); } } break;
            case 15: { GETP phase_rmsnorm_bf<false>(cx, (const bf16_t*)(ws + WS_XB), p->in[26] + l * 1024, (bf16_t*)(ws + WS_H), nullptr, TG); } break;
            case 16: { GETP
                pg8::Gemm g{(const bf16_t*)(ws + WS_H), (const bf16_t*)(ws + WS_WGU + l * SZ_WGU), TG, 5632, 1024, 1024}; pg8::StaticOrder S; S.init(TG, 5632, G, bx);
                pg8::EpiGU E{(bf16_t*)(ws + WS_P)}; pg8::gemm_phase(cx, lds, g, S, E); } break;
            case 17: { GETP
                pg8::Gemm g{(const bf16_t*)(ws + WS_P), (const bf16_t*)(ws + WS_WDN + l * SZ_WDN), TG, 1024, DFF, DFF}; pg8::StaticOrder S; S.init(TG, 1024, G, bx);
                pg8::EpiResidB<false> E{nullptr, (const bf16_t*)(ws + WS_XB), (bf16_t*)(ws + WS_XB)}; pg8::gemm_phase(cx, lds, g, S, E); } break;
            default: { GETP
                if (l == NL - 1) phase_rmsnorm_bf<true>(cx, (const bf16_t*)(ws + WS_XB), p->in[30], nullptr, p->out + xoff, TG); } break;
            }
        }
        if (again) { repeated = true; __syncthreads(); continue; }
        repeated = false;
        if (ph + 1 < ph_hi) { if (!need_sync) __syncthreads(); else if (ph == 0) grid.sync(); else xcd_barrier(xbar, cx.tid, (unsigned)cx.gd); }
        ++ph;
    }
}

extern "C" void kernel_launch(void* const* d_in, const int* in_sizes, int n_in, void* d_out, int out_size, void* d_ws, size_t ws_size, hipStream_t stream) {
    static int grid_blocks = 0;
    if (grid_blocks == 0) {
        if (n_in != 31 || out_size != TT * DM || ws_size < WS_END2) { fprintf(stderr, "kernel_launch: unexpected shapes (n_in %d out %d ws %zu need %zu)\n", n_in, out_size, ws_size, (size_t)WS_END2); grid_blocks = -1; return; }
        int dev = 0, cus = 0, per_cu = 0;
        hipGetDevice(&dev); hipDeviceGetAttribute(&cus, hipDeviceAttributeMultiprocessorCount, dev);
        if (hipFuncSetAttribute((const void*)mega, hipFuncAttributeMaxDynamicSharedMemorySize, LDS_BYTES) != hipSuccess) { fprintf(stderr, "kernel_launch: hipFuncSetAttribute failed\n"); grid_blocks = -1; return; }
        if (hipOccupancyMaxActiveBlocksPerMultiprocessor(&per_cu, (const void*)mega, NTHREADS, LDS_BYTES) != hipSuccess || per_cu < 1) { fprintf(stderr, "kernel_launch: occupancy query gave %d\n", per_cu); per_cu = 1; (void)hipGetLastError(); }
        grid_blocks = cus * per_cu;
    }
    if (grid_blocks < 0) return;
    Params p{};
    for (int i = 0; i < 31; ++i) p.in[i] = (const float*)d_in[i];
    p.out = (float*)d_out; p.ws = (unsigned char*)d_ws;
#if ONE_LAUNCH
    (void)hipMemsetAsync((unsigned char*)d_ws + WS_BAR, 0, XCD_BAR_WORDS_C * 4, stream);
    p.ph_lo = 0; p.ph_hi = N_PHASES;
    void* args[] = {&p};
    hipError_t e = hipLaunchCooperativeKernel((const void*)mega, dim3(grid_blocks), dim3(NTHREADS), args, LDS_BYTES, stream);
    if (e != hipSuccess) fprintf(stderr, "cooperative launch failed: %s (grid %d)\n", hipGetErrorString(e), grid_blocks);
#else
    for (int ph = 0; ph < N_PHASES; ++ph) { p.ph_lo = ph; p.ph_hi = ph + 1; hipLaunchKernelGGL(mega, dim3(grid_blocks), dim3(NTHREADS), LDS_BYTES, stream, p); }
#endif
}
```

```cpp
#include <hip/hip_runtime.h>
#include <hip/hip_cooperative_groups.h>
#include <cstdio>
namespace cg = cooperative_groups;

#define LAS __attribute__((address_space(3)))
typedef unsigned short bf16_t;
typedef short bf16x8 __attribute__((ext_vector_type(8)));
typedef float f32x4 __attribute__((ext_vector_type(4)));
typedef float f32x2 __attribute__((ext_vector_type(2)));
typedef unsigned u32x4 __attribute__((ext_vector_type(4)));
typedef unsigned u32x2 __attribute__((ext_vector_type(2)));

#ifndef REPEAT_MASK
#define REPEAT_MASK 0
#endif
#ifndef ONE_LAUNCH
#define ONE_LAUNCH 1
#endif

constexpr int DM = 1024, NB = 32, SEQ = 2048, NL = 2;
constexpr int TT = NB * SEQ;
constexpr int NGRP = 2;
constexpr int TG = TT / NGRP;
constexpr int GBATCH = NB / NGRP;
constexpr int NIN = 6688, NP = 3584, NPP = 3584;
constexpr int OFF_SG = 640, OFF_RW = 1664;
constexpr int DFF = 2816;
constexpr int LDS_MAIN = 136 * 1024;
constexpr int LDS_BYTES = LDS_MAIN + 16;
constexpr int XCD_BAR_WORDS_C = 3456;
constexpr int NTHREADS = 512;

constexpr size_t al256(size_t x) { return (x + 255) & ~(size_t)255; }
constexpr size_t SZ_WIN = (size_t)NPP * 1024 * 2, SZ_WG = (size_t)3072 * 1024 * 2, SZ_WUQ = (size_t)768 * 384 * 2, SZ_WUKV = (size_t)1024 * 256 * 2,
                 SZ_WLORA = (size_t)2560 * 384 * 2, SZ_WBR = (size_t)3 * 1024 * 512 * 2, SZ_WOUT = (size_t)1024 * 1024 * 2,
                 SZ_WGU = (size_t)5632 * 1024 * 2, SZ_WDN = (size_t)1024 * 2816 * 2, SZ_WSG = (size_t)8 * 128 * 128 * 2;
constexpr size_t WS_WIN = 0;
constexpr size_t WS_WG = WS_WIN + NL * SZ_WIN;
constexpr size_t WS_WUQ = WS_WG + NL * SZ_WG;
constexpr size_t WS_WUKV = WS_WUQ + NL * SZ_WUQ;
constexpr size_t WS_WLORA = WS_WUKV + NL * SZ_WUKV;
constexpr size_t WS_WBR = WS_WLORA + NL * SZ_WLORA;
constexpr size_t WS_WOUT = WS_WBR + NL * SZ_WBR;
constexpr size_t WS_WGU = WS_WOUT + NL * SZ_WOUT;
constexpr size_t WS_WDN = WS_WGU + NL * SZ_WGU;
constexpr size_t WS_WSG = WS_WDN + NL * SZ_WDN;
constexpr size_t SZ_WKR = (size_t)256 * 1024 * 2;
constexpr size_t WS_WKR = al256(WS_WSG + NL * SZ_WSG);
constexpr size_t WS_H = al256(WS_WKR + NL * SZ_WKR);
constexpr size_t WS_P = WS_H + (size_t)TG * 1024 * 2;
constexpr size_t WS_Q = WS_P + (size_t)TG * NP * 2;
constexpr size_t WS_KV = WS_Q + (size_t)TG * 768 * 2;
constexpr size_t WS_KR = WS_KV + (size_t)TG * 1024 * 2;
constexpr size_t WS_CS = WS_KR + (size_t)TG * 32 * 2;
constexpr size_t WS_YA = WS_CS + (size_t)TG * 32 * 4;
constexpr size_t WS_YB = WS_YA + (size_t)TG * 512 * 2;
constexpr size_t WS_YC = WS_YB + (size_t)TG * 512 * 2;
constexpr size_t WS_LIN = WS_YC + (size_t)TG * 512 * 2;
constexpr size_t WS_RKV = WS_LIN + (size_t)TG * 384 * 2;
constexpr size_t WS_KN = WS_RKV + (size_t)TG * 1536 * 2;
constexpr size_t WS_LOUT = WS_KN + (size_t)TG * 8 * 4;
constexpr size_t WS_YD = WS_LOUT + (size_t)TG * 2560 * 2;
constexpr size_t WS_CQN = WS_YD;
constexpr size_t WS_CKVN = WS_YD + (size_t)TG * 384 * 2;
constexpr size_t WS_XB = al256(WS_YD + (size_t)2 * TG * 512 * 2);
constexpr size_t WS_END = WS_XB + (size_t)TG * 1024 * 2;
constexpr size_t WS_BAR = al256(WS_END);
constexpr size_t WS_END2 = WS_BAR + XCD_BAR_WORDS_C * 4;
static_assert(WS_END2 <= ((size_t)1 << 30), "workspace map exceeds 1 GiB");

struct Ctx { int tid, bx, gd; };
__device__ __forceinline__ float bf2f(unsigned b) { return __uint_as_float(b << 16); }
__device__ __forceinline__ float bflo(unsigned w) { return __uint_as_float(w << 16); }
__device__ __forceinline__ float bfhi(unsigned w) { return __uint_as_float(w & 0xffff0000u); }
typedef __bf16 bf16x2_t __attribute__((ext_vector_type(2)));
__device__ __forceinline__ unsigned pk2(float lo, float hi) { const f32x2 v = {lo, hi}; const bf16x2_t b = __builtin_convertvector(v, bf16x2_t); return __builtin_bit_cast(unsigned, b); }
__device__ __forceinline__ unsigned f2bf(float f) { return pk2(f, 0.0f); }
__device__ __forceinline__ float sigmoidf_(float x) { return __builtin_amdgcn_rcpf(1.0f + __expf(-x)); }
__device__ __forceinline__ float tanhf_(float y) { return 1.0f - 2.0f * __builtin_amdgcn_rcpf(__expf(2.0f * y) + 1.0f); }
__device__ __forceinline__ float gelu_tanh(float x) { return 0.5f * x * (1.0f + tanhf_(0.7978845608028654f * (x + 0.044715f * x * x * x))); }
__device__ __forceinline__ void lds_barrier() { asm volatile("s_waitcnt lgkmcnt(0)" ::: "memory"); __builtin_amdgcn_s_barrier(); asm volatile("" ::: "memory"); }
template <int CTRL> __device__ __forceinline__ float dppf(float v) { return __int_as_float(__builtin_amdgcn_update_dpp(0, __float_as_int(v), CTRL, 0xF, 0xF, true)); }
__device__ __forceinline__ float red16(float v) {
    v += dppf<0xB1>(v);
    v += dppf<0x4E>(v);
    v += dppf<0x141>(v);
    v += dppf<0x140>(v);
    return v;
}


__device__ __forceinline__ float sum_swap16(float v) { const auto r = __builtin_amdgcn_permlane16_swap(__float_as_uint(v), __float_as_uint(v), false, false); return __uint_as_float(r[0]) + __uint_as_float(r[1]); }
__device__ __forceinline__ float sum_swap32(float v) { const auto r = __builtin_amdgcn_permlane32_swap(__float_as_uint(v), __float_as_uint(v), false, false); return __uint_as_float(r[0]) + __uint_as_float(r[1]); }
__device__ __forceinline__ float max_swap16(float v) { const auto r = __builtin_amdgcn_permlane16_swap(__float_as_uint(v), __float_as_uint(v), false, false); return fmaxf(__uint_as_float(r[0]), __uint_as_float(r[1])); }
__device__ __forceinline__ float max_swap32(float v) { const auto r = __builtin_amdgcn_permlane32_swap(__float_as_uint(v), __float_as_uint(v), false, false); return fmaxf(__uint_as_float(r[0]), __uint_as_float(r[1])); }
__device__ __forceinline__ float wsum(float v) { return sum_swap32(sum_swap16(red16(v))); }
__device__ __forceinline__ float hsum32(float v) { return sum_swap16(red16(v)); }
__device__ __forceinline__ float red8(float v) { v += dppf<0xB1>(v); v += dppf<0x4E>(v); v += dppf<0x141>(v); return v; }

#define XB_TMO      128
#define XB_XCNT(j)  (256  + 64 * (j))
#define XB_XSUB(j)  (1280 + 64 * (j))
#define XB_XGEN(j)  (2304 + 64 * (j))
#define XB_TOP      3328
#define XB_TOPGEN   3392
#define XCD_BAR_WORDS 3456
#define XB_SPIN_CAP (1u << 22)
__device__ __forceinline__ unsigned xb_ld(unsigned* p)              { return __hip_atomic_load(p, __ATOMIC_RELAXED, __HIP_MEMORY_SCOPE_AGENT); }
__device__ __forceinline__ unsigned xb_add(unsigned* p, unsigned v) { return __hip_atomic_fetch_add(p, v, __ATOMIC_RELAXED, __HIP_MEMORY_SCOPE_AGENT); }
__device__ __forceinline__ unsigned xb_xcc_id() { return (unsigned)__builtin_amdgcn_s_getreg((3 << 11) | 20) & 0xFu; }
#define XB_SPIN(cond, bar) do { unsigned _sp = 0; while (cond) { __builtin_amdgcn_s_sleep(1); \
    if ((++_sp & 255u) == 0u) { if (xb_ld(&(bar)[XB_TMO])) break; if (_sp > XB_SPIN_CAP) { atomicAdd(&(bar)[XB_TMO], 1u); break; } } } } while (0)
struct XcdBarrier { unsigned* bar; unsigned x; volatile LAS unsigned* st; };
__device__ __forceinline__ void xcd_barrier_complete(unsigned* bar, unsigned x, unsigned G, unsigned& nloc, unsigned& nx) {
    unsigned sum, cnt, mine, sp = 0u;
    for (;;) {
        sum = 0u; cnt = 0u; mine = 0u;
#pragma unroll
        for (unsigned j = 0; j < 16; ++j) { const unsigned c = xb_ld(&bar[XB_XCNT(j)]); sum += c; cnt += (c > 0u) ? 1u : 0u; mine = (j == x) ? c : mine; }
        if (sum == G) break;
        __builtin_amdgcn_s_sleep(1);
        if ((++sp & 255u) == 0u) { if (xb_ld(&bar[XB_TMO])) break; if (sp > XB_SPIN_CAP) { atomicAdd(&bar[XB_TMO], 1u); break; } }
    }
    nloc = mine > 0u ? mine : 1u; nx = cnt > 0u ? cnt : 1u;
}
__device__ __forceinline__ void xcd_barrier(const XcdBarrier& b, int tid, unsigned G) {
    asm volatile("s_waitcnt vmcnt(0)" ::: "memory");
    __syncthreads();
    if (tid == 0) {
        unsigned* bar = b.bar;
        __builtin_amdgcn_s_waitcnt(0);
        unsigned nloc = b.st[0], nx = b.st[1];
        if (nloc == 0u) { xcd_barrier_complete(bar, b.x, G, nloc, nx); b.st[0] = nloc; b.st[1] = nx; }
        const unsigned old = xb_add(&bar[XB_XSUB(b.x)], 1u);
        const unsigned gen = old / nloc;
        if (old + 1u == (gen + 1u) * nloc) {
            __builtin_amdgcn_fence(__ATOMIC_RELEASE, "agent");
            asm volatile("s_waitcnt vmcnt(0)" ::: "memory");
            const unsigned og = xb_add(&bar[XB_TOP], 1u);
            const unsigned tg = og / nx;
            if (og + 1u == (tg + 1u) * nx) xb_add(&bar[XB_TOPGEN], 1u);
            else XB_SPIN(xb_ld(&bar[XB_TOPGEN]) == tg, bar);
            __builtin_amdgcn_fence(__ATOMIC_ACQUIRE, "agent");
            xb_add(&bar[XB_XGEN(b.x)], 1u);
            asm volatile("s_waitcnt vmcnt(0)" ::: "memory");
        } else {
            XB_SPIN(xb_ld(&bar[XB_XGEN(b.x)]) == gen, bar);
            __builtin_amdgcn_fence(__ATOMIC_ACQUIRE, "agent");
            asm volatile("s_waitcnt vmcnt(0)" ::: "memory");
        }
    }
    __syncthreads();
}

namespace pg8 {
constexpr int BM = 256, BK = 64, HALF = 128, HTB = HALF * BK * 2, STAGE_BYTES = 8 * HTB, NXCD = 8, WGM = 8;
__host__ __device__ __forceinline__ int lds_byte(int r, int c) { const int st = (r >> 4) * 2 + (c >> 5), rr = r & 15, cc = c & 31, ob = rr * 64 + cc * 2; return st * 1024 + (ob ^ (((ob >> 9) & 1) << 5)); }
__host__ __device__ __forceinline__ void stage_rc(int b, int& R, int& C) { const int st = b / 1024, sb = b % 1024, swz = sb ^ (((sb >> 9) & 1) << 5); R = (st >> 1) * 16 + swz / 64; C = (st & 1) * 32 + (swz % 64) / 2; }
__host__ __device__ __forceinline__ int perm32(int rho) { const int n = rho >> 4, i = rho & 15; return 8 * (i >> 2) + 4 * n + (i & 3); }
struct Unit { int pm, pn; };
struct Gemm { const bf16_t* A; const bf16_t* Bt; int M, N, K, lda; };
struct StaticOrder {
    int nM, nN, nwg, G, c;
    __device__ void init(int M, int N, int G_, int c_) { nM = M / BM; nN = N / BM; nwg = nM * nN; G = G_; c = c_; }
    __device__ bool next(int i, Unit& u) const {
        const long L = (long)i * G + c; if (L >= nwg) return false;
        int wgid = (int)L; { const int q = nwg / NXCD, r = nwg % NXCD, xcd = wgid % NXCD, off = wgid / NXCD; wgid = (xcd < r ? xcd * (q + 1) : r * (q + 1) + (xcd - r) * q) + off; }
        const int nig = WGM * nN, gid = wgid / nig, fm = gid * WGM, gsz = (nM - fm) < WGM ? (nM - fm) : WGM;
        u.pm = fm + ((wgid % nig) % gsz); u.pn = (wgid % nig) / gsz; return true;
    }
};
__device__ __forceinline__ unsigned cvt_pk_bf16(float lo, float hi) { return pk2(lo, hi); }

template <class Epi>
__device__ __forceinline__ void gemm_phase(const Ctx cx, LAS unsigned char* lds, const Gemm g, const StaticOrder& S, const Epi& E) {
    const int tid = cx.tid, wid = __builtin_amdgcn_readfirstlane(tid >> 6), lane = tid & 63, wr = wid >> 2, wc = wid & 3, fr = lane & 15, fq = lane >> 4;
    int K = g.K, lda = g.lda; asm volatile("" : "+s"(K), "+s"(lda));
    const int nt = K / BK;
    unsigned voffA[2], voffB[2];
#pragma unroll
    for (int i = 0; i < 2; ++i) { int R, C; stage_rc(tid * 16 + i * 8192, R, C); const int Rb = Epi::PERM ? ((R & ~31) + perm32(R & 31)) : R;
        voffA[i] = (unsigned)(R * lda + C) * 2u; voffB[i] = (unsigned)(Rb * K + C) * 2u; }
    const size_t kstep = (size_t)(BK * 2);
    const size_t hstepA = (size_t)HALF * lda * 2, hstepB = (size_t)HALF * K * 2;
    const size_t tstepA = 2 * hstepA, tstepB = 2 * hstepB;
    const unsigned ldsw = (unsigned)wid * 1024u;
    const int aoff = lds_byte(wr * 64 + fr, fq * 8), boff = lds_byte(wc * 32 + fr, fq * 8);
#define PG8_SA(b, h) (((b) * 2 + (h)) * HTB)
#define PG8_SB(b, h) ((4 + (b) * 2 + (h)) * HTB)
#define PG8_STAGE(bufoff, gbase, voff) do { _Pragma("unroll") for (int _i = 0; _i < 2; ++_i) \
        __builtin_amdgcn_global_load_lds((const unsigned*)((const char*)(gbase) + (voff)[_i]), (LAS unsigned*)(lds + (bufoff) + ldsw + _i * 8192), 16, 0, 0); } while (0)
#define PG8_LDA(dst, b, h) do { _Pragma("unroll") for (int m = 0; m < 4; ++m) _Pragma("unroll") for (int k = 0; k < 2; ++k) dst[m][k] = *(const LAS bf16x8*)(lds + PG8_SA(b, h) + aoff + m * 2048 + k * 1024); } while (0)
#define PG8_LDB(dst, b, h) do { _Pragma("unroll") for (int n = 0; n < 2; ++n) _Pragma("unroll") for (int k = 0; k < 2; ++k) dst[n][k] = *(const LAS bf16x8*)(lds + PG8_SB(b, h) + boff + n * 2048 + k * 1024); } while (0)
#define PG8_MMA(ai, bj, At, Bt) do { __builtin_amdgcn_s_setprio(1); _Pragma("unroll") for (int m = 0; m < 4; ++m) _Pragma("unroll") for (int n = 0; n < 2; ++n) _Pragma("unroll") for (int k = 0; k < 2; ++k) \
        acc[ai][bj][m][n] = __builtin_amdgcn_mfma_f32_16x16x32_bf16(Bt[n][k], At[m][k], acc[ai][bj][m][n], 0, 0, 0); __builtin_amdgcn_s_setprio(0); } while (0)
#define PG8_WAIT_V(n) asm volatile("s_waitcnt vmcnt(" #n ")" ::: "memory")
#define PG8_WAIT_L(n) asm volatile("s_waitcnt lgkmcnt(" #n ")" ::: "memory")
#define PG8_BAR __builtin_amdgcn_s_barrier()
#define PG8_SCHED __builtin_amdgcn_sched_barrier(0)
    Unit cur, nxt; int ui = 0;
    if (!S.next(0, cur)) return;
    f32x4 acc[2][2][4][2];
#pragma unroll
    for (int a = 0; a < 2; ++a)
#pragma unroll
        for (int b = 0; b < 2; ++b)
#pragma unroll
            for (int m = 0; m < 4; ++m)
#pragma unroll
                for (int n = 0; n < 2; ++n) acc[a][b][m][n] = (f32x4){0.f, 0.f, 0.f, 0.f};
    bf16x8 At[4][2], B0[2][2], B1[2][2];
    const char* cA = (const char*)g.A + (size_t)cur.pm * tstepA; const char* cB = (const char*)g.Bt + (size_t)cur.pn * tstepB;
    PG8_STAGE(PG8_SB(0, 0), cB, voffB); PG8_STAGE(PG8_SA(0, 0), cA, voffA); PG8_STAGE(PG8_SB(0, 1), cB + hstepB, voffB); PG8_STAGE(PG8_SA(0, 1), cA + hstepA, voffA);
    if (wr == 1) PG8_BAR;
    PG8_WAIT_V(4); PG8_BAR;
    PG8_STAGE(PG8_SB(1, 0), cB + kstep, voffB); PG8_STAGE(PG8_SA(1, 0), cA + kstep, voffA); PG8_STAGE(PG8_SB(1, 1), cB + hstepB + kstep, voffB);
    PG8_WAIT_V(6); PG8_BAR;
    for (;;) {
        const bool has_next = S.next(ui + 1, nxt);
        const char* nA = has_next ? (const char*)g.A + (size_t)nxt.pm * tstepA : cA; const char* nB = has_next ? (const char*)g.Bt + (size_t)nxt.pn * tstepB : cB;
#pragma unroll 1
        for (int t = 0; t < nt; t += 2) {
            const bool last = (t == nt - 2);
            const char* a1 = cA + (size_t)(t + 1) * kstep;
            const char* a2 = last ? nA : cA + (size_t)(t + 2) * kstep; const char* b2 = last ? nB : cB + (size_t)(t + 2) * kstep;
            const char* a3 = a2 + kstep; const char* b3 = b2 + kstep;
            PG8_LDB(B0, 0, 0); PG8_SCHED; PG8_LDA(At, 0, 0); PG8_STAGE(PG8_SA(1, 1), a1 + hstepA, voffA);
            PG8_WAIT_L(8); PG8_BAR; PG8_WAIT_L(0); PG8_MMA(0, 0, At, B0); PG8_BAR; PG8_SCHED;
            PG8_LDB(B1, 0, 1); PG8_STAGE(PG8_SB(0, 0), b2, voffB);
            PG8_BAR; PG8_WAIT_L(0); PG8_MMA(0, 1, At, B1); PG8_BAR;
            PG8_LDA(At, 0, 1); PG8_STAGE(PG8_SA(0, 0), a2, voffA);
            PG8_BAR; PG8_WAIT_L(0); PG8_MMA(1, 0, At, B0); PG8_BAR; PG8_SCHED;
            PG8_STAGE(PG8_SB(0, 1), b2 + hstepB, voffB);
            PG8_WAIT_V(6); PG8_BAR; PG8_MMA(1, 1, At, B1); PG8_BAR;
            PG8_LDB(B0, 1, 0); PG8_SCHED; PG8_LDA(At, 1, 0); PG8_STAGE(PG8_SA(0, 1), a2 + hstepA, voffA);
            PG8_WAIT_L(8); PG8_BAR; PG8_WAIT_L(0); PG8_MMA(0, 0, At, B0); PG8_BAR; PG8_SCHED;
            PG8_LDB(B1, 1, 1); PG8_STAGE(PG8_SB(1, 0), b3, voffB);
            PG8_BAR; PG8_WAIT_L(0); PG8_MMA(0, 1, At, B1); PG8_BAR;
            PG8_LDA(At, 1, 1); PG8_STAGE(PG8_SA(1, 0), a3, voffA);
            PG8_BAR; PG8_WAIT_L(0); PG8_MMA(1, 0, At, B0); PG8_BAR; PG8_SCHED;
            PG8_STAGE(PG8_SB(1, 1), b3 + hstepB, voffB);
            PG8_WAIT_V(6); PG8_BAR; PG8_MMA(1, 1, At, B1); PG8_BAR;
        }
        E(acc, cur, wr, wc, fr, fq);
        if (!has_next) break;
#pragma unroll
        for (int a = 0; a < 2; ++a)
#pragma unroll
            for (int b = 0; b < 2; ++b)
#pragma unroll
                for (int m = 0; m < 4; ++m)
#pragma unroll
                    for (int n = 0; n < 2; ++n) acc[a][b][m][n] = (f32x4){0.f, 0.f, 0.f, 0.f};
        cur = nxt; cA = nA; cB = nB; ++ui;
    }
    PG8_WAIT_V(0);
    if (wr == 0) PG8_BAR;
    PG8_BAR;
#undef PG8_SA
#undef PG8_SB
#undef PG8_STAGE
#undef PG8_LDA
#undef PG8_LDB
#undef PG8_MMA
#undef PG8_WAIT_V
#undef PG8_WAIT_L
#undef PG8_BAR
#undef PG8_SCHED
}

#define EPI_ARGS const f32x4 (&acc)[2][2][4][2], const Unit& u, int wr, int wc, int fr, int fq
#define FOR_AIM _Pragma("unroll") for (int ai = 0; ai < 2; ++ai) _Pragma("unroll") for (int m = 0; m < 4; ++m)

struct EpiStore {
    static constexpr bool PERM = true;
    bf16_t* O; int ldc; int ncols;
    __device__ __forceinline__ void operator()(EPI_ARGS) const {
        const int row0 = u.pm * BM + wr * 64 + fr, col0 = u.pn * BM + wc * 32 + 8 * fq;
        FOR_AIM { const int row = row0 + ai * HALF + m * 16;
#pragma unroll
            for (int bj = 0; bj < 2; ++bj) { const int col = col0 + bj * HALF; if (col < ncols) {
                const f32x4 v0 = acc[ai][bj][m][0], v1 = acc[ai][bj][m][1];
                u32x4 o; o[0] = cvt_pk_bf16(v0[0], v0[1]); o[1] = cvt_pk_bf16(v0[2], v0[3]); o[2] = cvt_pk_bf16(v1[0], v1[1]); o[3] = cvt_pk_bf16(v1[2], v1[3]);
                *(u32x4*)(O + (size_t)row * ldc + col) = o; } } }
    }
};
struct EpiQ {
    static constexpr bool PERM = false;
    bf16_t* O; const float* cs;
    __device__ __forceinline__ void operator()(EPI_ARGS) const {
        const float QS = 0.10206207261596575f * 1.4426950408889634f;
        const int row0 = u.pm * BM + wr * 64 + fr;
#pragma unroll
        for (int bj = 0; bj < 2; ++bj) { const int cb = u.pn * BM + bj * HALF + wc * 32; const bool rope = (cb % 96) == 64;
            FOR_AIM { const int row = row0 + ai * HALF + m * 16;
                f32x4 v0 = acc[ai][bj][m][0] * QS, v1 = acc[ai][bj][m][1] * QS;
                if (rope) { const f32x4 c4 = *(const f32x4*)(cs + (size_t)row * 32 + 4 * fq), s4 = *(const f32x4*)(cs + (size_t)row * 32 + 16 + 4 * fq);
                    const f32x4 o0 = v0 * c4 - v1 * s4, o1 = v0 * s4 + v1 * c4; v0 = o0; v1 = o1; }
                u32x2 a, b; a[0] = cvt_pk_bf16(v0[0], v0[1]); a[1] = cvt_pk_bf16(v0[2], v0[3]); b[0] = cvt_pk_bf16(v1[0], v1[1]); b[1] = cvt_pk_bf16(v1[2], v1[3]);
                *(u32x2*)(O + (size_t)row * 768 + cb + 4 * fq) = a; *(u32x2*)(O + (size_t)row * 768 + cb + 16 + 4 * fq) = b; } }
    }
};
struct EpiKR {
    static constexpr bool PERM = false;
    bf16_t* O; const float* cs;
    __device__ __forceinline__ void operator()(EPI_ARGS) const {
        if (u.pn != 0 || wc != 0) return;
        const int row0 = u.pm * BM + wr * 64 + fr;
        FOR_AIM { const int row = row0 + ai * HALF + m * 16;
            const f32x4 v0 = acc[ai][0][m][0], v1 = acc[ai][0][m][1];
            const f32x4 c4 = *(const f32x4*)(cs + (size_t)row * 32 + 4 * fq), s4 = *(const f32x4*)(cs + (size_t)row * 32 + 16 + 4 * fq);
            const f32x4 o0 = v0 * c4 - v1 * s4, o1 = v0 * s4 + v1 * c4;
            u32x2 a, b; a[0] = cvt_pk_bf16(o0[0], o0[1]); a[1] = cvt_pk_bf16(o0[2], o0[3]); b[0] = cvt_pk_bf16(o1[0], o1[1]); b[1] = cvt_pk_bf16(o1[2], o1[3]);
            *(u32x2*)(O + (size_t)row * 32 + 4 * fq) = a; *(u32x2*)(O + (size_t)row * 32 + 16 + 4 * fq) = b; }
    }
};
struct EpiLora {
    static constexpr bool PERM = true;
    bf16_t* O; const float* w0; const float* a0; int cbase;
    __device__ __forceinline__ void operator()(EPI_ARGS) const {
        const int row0 = u.pm * BM + wr * 64 + fr, col0 = cbase + u.pn * BM + wc * 32 + 8 * fq;
        const int tcol = cbase + u.pn * BM; const int kind = tcol < 1024 ? 0 : (tcol < 2048 ? 1 : 2);
#pragma unroll
        for (int bj = 0; bj < 2; ++bj) { const int col = col0 + bj * HALF;
            f32x4 b0 = (f32x4){0.f, 0.f, 0.f, 0.f}, b1 = b0;
            if (kind == 0) { b0 = *(const f32x4*)(w0 + col); b1 = *(const f32x4*)(w0 + col + 4); }
            else if (kind == 1) { b0 = *(const f32x4*)(a0 + col - 1024); b1 = *(const f32x4*)(a0 + col - 1020); }
            FOR_AIM { const int row = row0 + ai * HALF + m * 16;
                f32x4 v0 = acc[ai][bj][m][0] + b0, v1 = acc[ai][bj][m][1] + b1;
                if (kind == 0) {
#pragma unroll
                    for (int j = 0; j < 4; ++j) { v0[j] = 1.0f - __expf(-0.6065306597126334f * sigmoidf_(v0[j])); v1[j] = 1.0f - __expf(-0.6065306597126334f * sigmoidf_(v1[j])); } }
                else if (kind == 1) {
#pragma unroll
                    for (int j = 0; j < 4; ++j) { v0[j] = sigmoidf_(v0[j]); v1[j] = sigmoidf_(v1[j]); } }
                u32x4 o; o[0] = cvt_pk_bf16(v0[0], v0[1]); o[1] = cvt_pk_bf16(v0[2], v0[3]); o[2] = cvt_pk_bf16(v1[0], v1[1]); o[3] = cvt_pk_bf16(v1[2], v1[3]);
                *(u32x4*)(O + (size_t)row * 2560 + col) = o; } }
    }
};
struct EpiGate {
    static constexpr bool PERM = true;
    bf16_t* O; const float* bias;
    __device__ __forceinline__ void operator()(EPI_ARGS) const {
        const int row0 = u.pm * BM + wr * 64 + fr, col0 = u.pn * BM + wc * 32 + 8 * fq;
#pragma unroll
        for (int bj = 0; bj < 2; ++bj) { const int col = col0 + bj * HALF;
            const f32x4 b0 = *(const f32x4*)(bias + col) * -1.4426950408889634f, b1 = *(const f32x4*)(bias + col + 4) * -1.4426950408889634f;
            FOR_AIM { const int row = row0 + ai * HALF + m * 16;
                f32x4 v0, v1;
#pragma unroll
                for (int j = 0; j < 4; ++j) { v0[j] = __builtin_amdgcn_rcpf(1.0f + __builtin_amdgcn_exp2f(__builtin_fmaf(acc[ai][bj][m][0][j], -1.4426950408889634f, b0[j])));
                                              v1[j] = __builtin_amdgcn_rcpf(1.0f + __builtin_amdgcn_exp2f(__builtin_fmaf(acc[ai][bj][m][1][j], -1.4426950408889634f, b1[j]))); }
                u32x4 o; o[0] = cvt_pk_bf16(v0[0], v0[1]); o[1] = cvt_pk_bf16(v0[2], v0[3]); o[2] = cvt_pk_bf16(v1[0], v1[1]); o[3] = cvt_pk_bf16(v1[2], v1[3]);
                *(u32x4*)(O + (size_t)row * 3072 + col) = o; } }
    }
};
struct EpiBranch {
    static constexpr bool PERM = true;
    bf16_t* MG; const bf16_t* G; int nb;
    __device__ __forceinline__ void operator()(EPI_ARGS) const {
        const int row0 = u.pm * BM + wr * 64 + fr, col0 = u.pn * BM + wc * 32 + 8 * fq;
        FOR_AIM { const int row = row0 + ai * HALF + m * 16;
#pragma unroll
            for (int bj = 0; bj < 2; ++bj) { const int col = col0 + bj * HALF;
                const u32x4 gq = *(const u32x4*)(G + (size_t)row * 3072 + nb * 1024 + col);
                const f32x4 a0 = acc[ai][bj][m][0], a1 = acc[ai][bj][m][1];
                float v[8];
                v[0] = bflo(gq[0]) * a0[0]; v[1] = bfhi(gq[0]) * a0[1]; v[2] = bflo(gq[1]) * a0[2]; v[3] = bfhi(gq[1]) * a0[3];
                v[4] = bflo(gq[2]) * a1[0]; v[5] = bfhi(gq[2]) * a1[1]; v[6] = bflo(gq[3]) * a1[2]; v[7] = bfhi(gq[3]) * a1[3];
                bf16_t* dst = MG + (size_t)row * 1024 + col;
                if (nb > 0) { const u32x4 mq = *(const u32x4*)dst;
#pragma unroll
                    for (int j = 0; j < 4; ++j) { v[2 * j] += bflo(mq[j]); v[2 * j + 1] += bfhi(mq[j]); } }
                u32x4 o; o[0] = cvt_pk_bf16(v[0], v[1]); o[1] = cvt_pk_bf16(v[2], v[3]); o[2] = cvt_pk_bf16(v[4], v[5]); o[3] = cvt_pk_bf16(v[6], v[7]);
                *(u32x4*)dst = o; } }
    }
};
struct EpiResid {
    static constexpr bool PERM = false;
    const float* xin; float* xout;
    __device__ __forceinline__ void operator()(EPI_ARGS) const {
        const int row0 = u.pm * BM + wr * 64 + fr, col0 = u.pn * BM + wc * 32 + 4 * fq;
        FOR_AIM { const size_t ro = (size_t)(row0 + ai * HALF + m * 16) * 1024 + col0;
#pragma unroll
            for (int bj = 0; bj < 2; ++bj)
#pragma unroll
                for (int n = 0; n < 2; ++n) { const size_t o = ro + bj * HALF + n * 16; *(f32x4*)(xout + o) = *(const f32x4*)(xin + o) + acc[ai][bj][m][n]; } }
    }
};
template <bool IN_F32> struct EpiResidB {
    static constexpr bool PERM = true;
    const float* xin32; const bf16_t* xinb; bf16_t* xout;
    __device__ __forceinline__ void operator()(EPI_ARGS) const {
        const int row0 = u.pm * BM + wr * 64 + fr, col0 = u.pn * BM + wc * 32 + 8 * fq;
        FOR_AIM { const int row = row0 + ai * HALF + m * 16;
#pragma unroll
            for (int bj = 0; bj < 2; ++bj) { const size_t o = (size_t)row * 1024 + col0 + bj * HALF;
                const f32x4 a0 = acc[ai][bj][m][0], a1 = acc[ai][bj][m][1]; float v[8];
                if (IN_F32) { const f32x4 x0 = *(const f32x4*)(xin32 + o), x1 = *(const f32x4*)(xin32 + o + 4);
#pragma unroll
                    for (int j = 0; j < 4; ++j) { v[j] = x0[j] + a0[j]; v[4 + j] = x1[j] + a1[j]; } }
                else { const u32x4 xq = *(const u32x4*)(xinb + o);
                    v[0] = bflo(xq[0]) + a0[0]; v[1] = bfhi(xq[0]) + a0[1]; v[2] = bflo(xq[1]) + a0[2]; v[3] = bfhi(xq[1]) + a0[3];
                    v[4] = bflo(xq[2]) + a1[0]; v[5] = bfhi(xq[2]) + a1[1]; v[6] = bflo(xq[3]) + a1[2]; v[7] = bfhi(xq[3]) + a1[3]; }
                u32x4 w; w[0] = cvt_pk_bf16(v[0], v[1]); w[1] = cvt_pk_bf16(v[2], v[3]); w[2] = cvt_pk_bf16(v[4], v[5]); w[3] = cvt_pk_bf16(v[6], v[7]);
                *(u32x4*)(xout + o) = w; } }
    }
};
struct EpiGU {
    static constexpr bool PERM = true;
    bf16_t* O;
    __device__ __forceinline__ void operator()(EPI_ARGS) const {
        const int row0 = u.pm * BM + wr * 64 + fr, oc0 = u.pn * 128 + wc * 32 + 8 * fq;
        FOR_AIM { const int row = row0 + ai * HALF + m * 16; float v[8];
#pragma unroll
            for (int n = 0; n < 2; ++n) { const f32x4 gt = acc[ai][0][m][n], up = acc[ai][1][m][n];
#pragma unroll
                for (int j = 0; j < 4; ++j) v[4 * n + j] = gt[j] * sigmoidf_(gt[j]) * up[j]; }
            u32x4 o; o[0] = cvt_pk_bf16(v[0], v[1]); o[1] = cvt_pk_bf16(v[2], v[3]); o[2] = cvt_pk_bf16(v[4], v[5]); o[3] = cvt_pk_bf16(v[6], v[7]);
            *(u32x4*)(O + (size_t)row * DFF + oc0) = o; }
    }
};
}

template <class F> __device__ __forceinline__ void conv_t(const Ctx cx, float* tl, bf16_t* dst, int K, int N, F src) {
    const int tid = cx.tid; const int nk = K / 64, nn = N / 64, ntile = nk * nn;
    float rg[8];
    int t = cx.bx;
    if (t < ntile) { const int k0 = (t % nk) * 64, n0 = (t / nk) * 64;
#pragma unroll
        for (int i = 0; i < 8; ++i) rg[i] = src(k0 + (tid >> 6) + 8 * i, n0 + (tid & 63)); }
    for (; t < ntile; t += cx.gd) {
        const int k0 = (t % nk) * 64, n0 = (t / nk) * 64;
        lds_barrier();
#pragma unroll
        for (int i = 0; i < 8; ++i) tl[((tid >> 6) + 8 * i) * 65 + (tid & 63)] = rg[i];
        lds_barrier();
        const int tn = t + cx.gd;
        if (tn < ntile) { const int k1 = (tn % nk) * 64, n1 = (tn / nk) * 64;
#pragma unroll
            for (int i = 0; i < 8; ++i) rg[i] = src(k1 + (tid >> 6) + 8 * i, n1 + (tid & 63)); }
#pragma unroll
        for (int i = 0; i < 8; ++i) { const int n = (tid >> 6) + 8 * i, k = tid & 63; dst[(size_t)(n0 + n) * K + k0 + k] = (bf16_t)f2bf(tl[k * 65 + n]); }
    }
}

struct Params { const float* in[31]; float* out; unsigned char* ws; int ph_lo, ph_hi; };
typedef const __attribute__((opencl_constant)) Params* KP;
__device__ __forceinline__ KP get_kp() { auto k = __builtin_amdgcn_kernarg_segment_ptr(); asm volatile("" : "+s"(k)); return (KP)k; }

__device__ __forceinline__ void phase_convert(const Ctx cx, KP p, unsigned char* smem) {
    float* tl = (float*)smem; unsigned char* ws = p->ws;
    for (int l = 0; l < NL; ++l) {
        { const float* w = p->in[3] + (size_t)l * 1024 * NIN;
          conv_t(cx, tl, (bf16_t*)(ws + WS_WIN + l * SZ_WIN), 1024, NPP, [=](int k, int n) { return w[(size_t)k * NIN + (n < 640 ? n : n + 32)]; });
          conv_t(cx, tl, (bf16_t*)(ws + WS_WKR + l * SZ_WKR), 1024, 256, [=](int k, int n) { return n < 32 ? w[(size_t)k * NIN + 640 + n] : 0.0f; });
          conv_t(cx, tl, (bf16_t*)(ws + WS_WG + l * SZ_WG), 1024, 3072, [=](int k, int n) { return w[(size_t)k * NIN + 3616 + n]; }); }
        { const float* w = p->in[6] + (size_t)l * 384 * 768; conv_t(cx, tl, (bf16_t*)(ws + WS_WUQ + l * SZ_WUQ), 384, 768, [=](int k, int n) { return w[(size_t)k * 768 + n]; }); }
        { const float* w = p->in[8] + (size_t)l * 256 * 1024; conv_t(cx, tl, (bf16_t*)(ws + WS_WUKV + l * SZ_WUKV), 256, 1024, [=](int k, int n) { return w[(size_t)k * 1024 + n]; }); }
        { const float* w2 = p->in[15] + (size_t)l * 2 * 64 * 512; const float* a2 = p->in[17] + (size_t)l * 2 * 64 * 512; const float* g2 = p->in[18] + (size_t)l * 128 * 512;
          conv_t(cx, tl, (bf16_t*)(ws + WS_WLORA + l * SZ_WLORA), 256, 2048, [=](int k, int n) {
              const int blk = n >> 9, c = n & 511;
              if ((k >> 6) != blk) return 0.0f;
              return blk < 2 ? w2[(size_t)(blk * 64 + (k & 63)) * 512 + c] : a2[(size_t)((blk - 2) * 64 + (k & 63)) * 512 + c]; });
          conv_t(cx, tl, (bf16_t*)(ws + WS_WLORA + l * SZ_WLORA) + (size_t)2048 * 256, 256, 512, [=](int k, int n) { return k >= 128 ? g2[(size_t)(k - 128) * 512 + n] : 0.0f; }); }
        for (int nb = 0; nb < 3; ++nb) { const float* w = p->in[24] + (size_t)(l * 3 + nb) * 512 * 1024;
          conv_t(cx, tl, (bf16_t*)(ws + WS_WBR + l * SZ_WBR) + (size_t)nb * 1024 * 512, 512, 1024, [=](int k, int n) { return w[(size_t)k * 1024 + n]; }); }
        { const float* w = p->in[25] + (size_t)l * 1024 * 1024; conv_t(cx, tl, (bf16_t*)(ws + WS_WOUT + l * SZ_WOUT), 1024, 1024, [=](int k, int n) { return w[(size_t)k * 1024 + n]; }); }
        { const float* wg = p->in[27] + (size_t)l * 1024 * DFF; const float* wu = p->in[28] + (size_t)l * 1024 * DFF;
          conv_t(cx, tl, (bf16_t*)(ws + WS_WGU + l * SZ_WGU), 1024, 5632, [=](int k, int c) { const int j = (c >> 8) * 128 + (c & 127); return (c & 128) ? wu[(size_t)k * DFF + j] : wg[(size_t)k * DFF + j]; }); }
        { const float* w = p->in[29] + (size_t)l * DFF * 1024; conv_t(cx, tl, (bf16_t*)(ws + WS_WDN + l * SZ_WDN), DFF, 1024, [=](int k, int n) { return w[(size_t)k * 1024 + n]; }); }
    }
    { const float* w = p->in[11]; bf16_t* d = (bf16_t*)(ws + WS_WSG);
      for (size_t i = (size_t)cx.bx * NTHREADS + cx.tid; i < (size_t)NL * 8 * 128 * 128; i += (size_t)cx.gd * NTHREADS) d[i] = (bf16_t)f2bf(w[i]); }
}

__device__ __forceinline__ void phase_rmsnorm(const Ctx cx, const float* __restrict__ x, const float* __restrict__ g, bf16_t* __restrict__ h, int rows) {
    const int wv = cx.tid >> 6, lane = cx.tid & 63;
    constexpr int NR = 8;
    f32x4 g4[4];
#pragma unroll
    for (int i = 0; i < 4; ++i) g4[i] = *(const f32x4*)(g + i * 256 + lane * 4);
    for (int r0 = (cx.bx * 8 + wv) * NR; r0 < rows; r0 += cx.gd * 8 * NR) {
        f32x4 v[NR][4];
#pragma unroll
        for (int k = 0; k < NR; ++k)
#pragma unroll
            for (int i = 0; i < 4; ++i) v[k][i] = *(const f32x4*)(x + (size_t)(r0 + k) * 1024 + i * 256 + lane * 4);
#pragma unroll
        for (int k = 0; k < NR; ++k) { float ss = 0.f;
#pragma unroll
            for (int i = 0; i < 4; ++i) ss += v[k][i][0] * v[k][i][0] + v[k][i][1] * v[k][i][1] + v[k][i][2] * v[k][i][2] + v[k][i][3] * v[k][i][3];
            ss = wsum(ss); const float rs = rsqrtf(ss * (1.0f / 1024.0f) + 1e-6f);
#pragma unroll
            for (int i = 0; i < 4; ++i) { u32x2 o; o[0] = pk2(v[k][i][0] * rs * g4[i][0], v[k][i][1] * rs * g4[i][1]); o[1] = pk2(v[k][i][2] * rs * g4[i][2], v[k][i][3] * rs * g4[i][3]);
                *(u32x2*)(h + (size_t)(r0 + k) * 1024 + i * 256 + lane * 4) = o; } }
    }
}
template <bool FINAL> __device__ __forceinline__ void phase_rmsnorm_bf(const Ctx cx, const bf16_t* __restrict__ xb, const float* __restrict__ g, bf16_t* __restrict__ h, float* __restrict__ out, int rows) {
    const int wv = cx.tid >> 6, lane = cx.tid & 63;
    constexpr int NR = 8;
    float gg[16];
#pragma unroll
    for (int i = 0; i < 2; ++i)
#pragma unroll
        for (int e = 0; e < 8; ++e) gg[i * 8 + e] = g[i * 512 + lane * 8 + e];
    for (int r0 = (cx.bx * 8 + wv) * NR; r0 < rows; r0 += cx.gd * 8 * NR) {
        u32x4 q[NR][2];
#pragma unroll
        for (int k = 0; k < NR; ++k)
#pragma unroll
            for (int i = 0; i < 2; ++i) q[k][i] = *(const u32x4*)(xb + (size_t)(r0 + k) * 1024 + i * 512 + lane * 8);
#pragma unroll
        for (int k = 0; k < NR; ++k) { float v[16]; float ss = 0.f;
#pragma unroll
            for (int i = 0; i < 2; ++i)
#pragma unroll
                for (int j = 0; j < 4; ++j) { v[i * 8 + 2 * j] = bflo(q[k][i][j]); v[i * 8 + 2 * j + 1] = bfhi(q[k][i][j]); ss += v[i * 8 + 2 * j] * v[i * 8 + 2 * j] + v[i * 8 + 2 * j + 1] * v[i * 8 + 2 * j + 1]; }
            ss = wsum(ss); const float rs = rsqrtf(ss * (1.0f / 1024.0f) + 1e-6f);
#pragma unroll
            for (int i = 0; i < 2; ++i) {
                if (FINAL) { float* op = out + (size_t)(r0 + k) * 1024 + i * 512 + lane * 8;
                    *(f32x4*)op = (f32x4){v[i * 8] * rs * gg[i * 8], v[i * 8 + 1] * rs * gg[i * 8 + 1], v[i * 8 + 2] * rs * gg[i * 8 + 2], v[i * 8 + 3] * rs * gg[i * 8 + 3]};
                    *(f32x4*)(op + 4) = (f32x4){v[i * 8 + 4] * rs * gg[i * 8 + 4], v[i * 8 + 5] * rs * gg[i * 8 + 5], v[i * 8 + 6] * rs * gg[i * 8 + 6], v[i * 8 + 7] * rs * gg[i * 8 + 7]}; }
                else { u32x4 o;
#pragma unroll
                    for (int j = 0; j < 4; ++j) o[j] = pk2(v[i * 8 + 2 * j] * rs * gg[i * 8 + 2 * j], v[i * 8 + 2 * j + 1] * rs * gg[i * 8 + 2 * j + 1]);
                    *(u32x4*)(h + (size_t)(r0 + k) * 1024 + i * 512 + lane * 8) = o; } } }
    }
}
__device__ __forceinline__ void phase_final_norm(const Ctx cx, float* x, const float* __restrict__ g, int rows) {
    const int wv = cx.tid >> 6, lane = cx.tid & 63;
    constexpr int NR = 4;
    f32x4 g4[4];
#pragma unroll
    for (int i = 0; i < 4; ++i) g4[i] = *(const f32x4*)(g + i * 256 + lane * 4);
    for (int r0 = (cx.bx * 8 + wv) * NR; r0 < rows; r0 += cx.gd * 8 * NR) {
        f32x4 v[NR][4];
#pragma unroll
        for (int k = 0; k < NR; ++k)
#pragma unroll
            for (int i = 0; i < 4; ++i) v[k][i] = *(const f32x4*)(x + (size_t)(r0 + k) * 1024 + i * 256 + lane * 4);
#pragma unroll
        for (int k = 0; k < NR; ++k) { float ss = 0.f;
#pragma unroll
            for (int i = 0; i < 4; ++i) ss += v[k][i][0] * v[k][i][0] + v[k][i][1] * v[k][i][1] + v[k][i][2] * v[k][i][2] + v[k][i][3] * v[k][i][3];
            ss = wsum(ss); const float rs = rsqrtf(ss * (1.0f / 1024.0f) + 1e-6f);
#pragma unroll
            for (int i = 0; i < 4; ++i) *(f32x4*)(x + (size_t)(r0 + k) * 1024 + i * 256 + lane * 4) = v[k][i] * rs * g4[i]; }
    }
}

__device__ __forceinline__ void phase_prep(const Ctx cx, KP p, int l, int grp) {
    unsigned char* ws = p->ws;
    const bf16_t* P = (const bf16_t*)(ws + WS_P);
    bf16_t* CQN = (bf16_t*)(ws + WS_CQN); bf16_t* CKVN = (bf16_t*)(ws + WS_CKVN); bf16_t* KR = (bf16_t*)(ws + WS_KR); float* CS = (float*)(ws + WS_CS);
    bf16_t* RKV = (bf16_t*)(ws + WS_RKV); bf16_t* LIN = (bf16_t*)(ws + WS_LIN); float* KN = (float*)(ws + WS_KN);
    const int* positions = (const int*)p->in[1];
    const float* qg = p->in[5] + l * 384; const float* kvg = p->in[7] + l * 256;
    const float* mu = p->in[13] + l * 1920; const float* k_k = p->in[19] + l * 512;
    const int wv = cx.tid >> 6, lane = cx.tid & 63;
    const float inv_freq = 1.0f / powf(10000.0f, (float)(lane & 15) * (1.0f / 16.0f));
    for (int r = cx.bx * 8 + wv; r < TG; r += cx.gd * 8) {
        const bf16_t* pr = P + (size_t)r * NP;
        { float v[6]; float ss = 0.f;
#pragma unroll
          for (int i = 0; i < 3; ++i) { const unsigned w = *(const unsigned*)(pr + i * 128 + lane * 2); v[2 * i] = bflo(w); v[2 * i + 1] = bfhi(w); ss += v[2 * i] * v[2 * i] + v[2 * i + 1] * v[2 * i + 1]; }
          ss = wsum(ss); const float rs = rsqrtf(ss * (1.0f / 384.0f) + 1e-6f);
#pragma unroll
          for (int i = 0; i < 3; ++i) { const int c = i * 128 + lane * 2; *(unsigned*)(CQN + (size_t)r * 384 + c) = pk2(v[2 * i] * rs * qg[c], v[2 * i + 1] * rs * qg[c + 1]); } }
        { const u32x2 w = *(const u32x2*)(pr + 384 + lane * 4); float v[4] = {bflo(w[0]), bfhi(w[0]), bflo(w[1]), bfhi(w[1])};
          float ss = v[0] * v[0] + v[1] * v[1] + v[2] * v[2] + v[3] * v[3]; ss = wsum(ss); const float rs = rsqrtf(ss * (1.0f / 256.0f) + 1e-6f);
          const f32x4 g4 = *(const f32x4*)(kvg + lane * 4); u32x2 o; o[0] = pk2(v[0] * rs * g4[0], v[1] * rs * g4[1]); o[1] = pk2(v[2] * rs * g4[2], v[3] * rs * g4[3]);
          *(u32x2*)(CKVN + (size_t)r * 256 + lane * 4) = o; }
        if (lane < 16) {
          const float pos = (float)positions[(size_t)grp * TG + r];
          const float ang = pos * inv_freq; const float rev = __builtin_amdgcn_fractf(ang * 0.15915494309189535f);
          const float c = __builtin_amdgcn_cosf(rev), s = __builtin_amdgcn_sinf(rev);
          CS[(size_t)r * 32 + lane] = c; CS[(size_t)r * 32 + 16 + lane] = s; }
        { const bf16_t* pz = pr + OFF_RW; const int s = r & (SEQ - 1); const bool hasp = s > 0, hasn = s < SEQ - 1;
#pragma unroll
          for (int ig = 0; ig < 3; ++ig) {
              unsigned wz[5], wp[5], wn[5]; f32x2 m2[5];
#pragma unroll
              for (int j = 0; j < 5; ++j) { const int c = (ig * 5 + j) * 128 + lane * 2;
                  wz[j] = *(const unsigned*)(pz + c); wp[j] = hasp ? *(const unsigned*)(pz - NP + c) : 0u; wn[j] = hasn ? *(const unsigned*)(pz + NP + c) : 0u; m2[j] = *(const f32x2*)(mu + c); }
#pragma unroll
              for (int j = 0; j < 5; ++j) { const int i = ig * 5 + j;
                  const float z0 = bflo(wz[j]), z1 = bfhi(wz[j]);
                  const float y0 = z0 + m2[j][0] * (0.5f * (bflo(wp[j]) + bflo(wn[j])) - z0), y1 = z1 + m2[j][1] * (0.5f * (bfhi(wp[j]) + bfhi(wn[j])) - z1);
                  if (i < 12) { *(unsigned*)(RKV + ((size_t)r * 3 + (i >> 2)) * 512 + (i & 3) * 128 + lane * 2) = pk2(y0, y1);
                      if (i >= 4 && i < 8) { const int kc = (i - 4) * 128 + lane * 2; const float a = y0 * k_k[kc], b = y1 * k_k[kc + 1]; float ss = a * a + b * b;
                          ss = hsum32(ss);
                          const float inv = 1.0f / fmaxf(sqrtf(ss), 1e-12f); if ((lane & 31) == 0) KN[(size_t)r * 8 + (i - 4) * 2 + (lane >> 5)] = inv; } }
                  else if (i == 12) *(unsigned*)(LIN + (size_t)r * 384 + lane * 2) = pk2(tanhf_(y0), tanhf_(y1));
                  else if (i == 13) *(unsigned*)(LIN + (size_t)r * 384 + 128 + lane * 2) = pk2(y0, y1);
                  else *(unsigned*)(LIN + (size_t)r * 384 + 256 + lane * 2) = pk2(sigmoidf_(y0), sigmoidf_(y1)); } } }
    }
}

__device__ __forceinline__ void phase_sg(const Ctx cx, KP p, int l, unsigned char* smem) {
    unsigned char* ws = p->ws;
    const bf16_t* P = (const bf16_t*)(ws + WS_P); bf16_t* YB = (bf16_t*)(ws + WS_YB);
    const bf16_t* Wsg = (const bf16_t*)(ws + WS_WSG) + (size_t)l * 8 * 128 * 128;
    const float* lng = p->in[9] + l * 512; const float* lnb = p->in[10] + l * 512; const float* sgb = p->in[12] + l * 8 * 128;
    constexpr int VP = 520;
    bf16_t* vn = (bf16_t*)smem;
    const int tid = cx.tid, wv = tid >> 6, lane = tid & 63, l15 = lane & 15, g4 = lane >> 4;
    for (int it = cx.bx; it < TG / 128; it += cx.gd) {
        const int r0 = it * 128;
        __syncthreads();
        f32x4 ga = *(const f32x4*)(lng + lane * 8), gb = *(const f32x4*)(lng + lane * 8 + 4), ba = *(const f32x4*)(lnb + lane * 8), bb = *(const f32x4*)(lnb + lane * 8 + 4);
        for (int tb = 0; tb < 16; tb += 4) { u32x4 raw4[4];
#pragma unroll
          for (int q = 0; q < 4; ++q) raw4[q] = *(const u32x4*)(P + (size_t)(r0 + wv * 16 + tb + q) * NP + OFF_SG + 512 + lane * 8);
#pragma unroll
          for (int q = 0; q < 4; ++q) { const int t = wv * 16 + tb + q; const u32x4 raw = raw4[q];
            float x[8]; float sm = 0.f;
#pragma unroll
            for (int j = 0; j < 4; ++j) { x[2 * j] = gelu_tanh(bflo(raw[j])); x[2 * j + 1] = gelu_tanh(bfhi(raw[j])); sm += x[2 * j] + x[2 * j + 1]; }
            const float mean = wsum(sm) * (1.0f / 512.0f); float sq = 0.f;
#pragma unroll
            for (int j = 0; j < 8; ++j) { x[j] -= mean; sq += x[j] * x[j]; }
            const float rs = rsqrtf(wsum(sq) * (1.0f / 512.0f) + 1e-5f);
            u32x4 o; o[0] = pk2(x[0] * rs * ga[0] + ba[0], x[1] * rs * ga[1] + ba[1]); o[1] = pk2(x[2] * rs * ga[2] + ba[2], x[3] * rs * ga[3] + ba[3]);
            o[2] = pk2(x[4] * rs * gb[0] + bb[0], x[5] * rs * gb[1] + bb[1]); o[3] = pk2(x[6] * rs * gb[2] + bb[2], x[7] * rs * gb[3] + bb[3]);
            *(u32x4*)(vn + t * VP + lane * 8) = o; } }
        __syncthreads();
        const int gi = wv;
        for (int half = 0; half < 2; ++half) {
            f32x4 acc[4][4];
#pragma unroll
            for (int a = 0; a < 4; ++a)
#pragma unroll
                for (int b = 0; b < 4; ++b) acc[a][b] = (f32x4){0.f, 0.f, 0.f, 0.f};
#pragma unroll 1
            for (int ks = 0; ks < 4; ++ks) {
                bf16x8 af[4];
#pragma unroll
                for (int dt = 0; dt < 4; ++dt)
#pragma unroll
                    for (int j = 0; j < 8; ++j) af[dt][j] = (short)vn[(ks * 32 + g4 * 8 + j) * VP + gi * 64 + dt * 16 + l15];
#pragma unroll
                for (int mt = 0; mt < 4; ++mt) {
                    const bf16x8 bfr = *(const bf16x8*)(Wsg + ((size_t)gi * 128 + (half * 4 + mt) * 16 + l15) * 128 + ks * 32 + g4 * 8);
#pragma unroll
                    for (int dt = 0; dt < 4; ++dt) acc[mt][dt] = __builtin_amdgcn_mfma_f32_16x16x32_bf16(af[dt], bfr, acc[mt][dt], 0, 0, 0);
                }
            }
#pragma unroll
            for (int mt = 0; mt < 4; ++mt) { const int t = (half * 4 + mt) * 16 + l15; const float bias = sgb[gi * 128 + t];
#pragma unroll
                for (int dt = 0; dt < 4; ++dt) { const int d0 = gi * 64 + dt * 16 + g4 * 4;
                    const u32x2 uq = *(const u32x2*)(P + (size_t)(r0 + t) * NP + OFF_SG + d0);
                    u32x2 o; o[0] = pk2(gelu_tanh(bflo(uq[0])) * (acc[mt][dt][0] + bias), gelu_tanh(bfhi(uq[0])) * (acc[mt][dt][1] + bias));
                    o[1] = pk2(gelu_tanh(bflo(uq[1])) * (acc[mt][dt][2] + bias), gelu_tanh(bfhi(uq[1])) * (acc[mt][dt][3] + bias));
                    *(u32x2*)(YB + (size_t)(r0 + t) * 512 + d0) = o; } }
        }
    }
}

__device__ __forceinline__ bf16x8 pack4z(float a, float b, float c, float d) { u32x4 t; t[0] = pk2(a, b); t[1] = pk2(c, d); t[2] = 0u; t[3] = 0u; return __builtin_bit_cast(bf16x8, t); }
__device__ __forceinline__ void phase_scan(const Ctx cx, KP p, int l, unsigned char* smem) {
    unsigned char* ws = p->ws;
    const bf16_t* __restrict__ RKV = (const bf16_t*)(ws + WS_RKV); const bf16_t* __restrict__ LOUT = (const bf16_t*)(ws + WS_LOUT); const float* __restrict__ KN = (const float*)(ws + WS_KN);
    bf16_t* __restrict__ YD = (bf16_t*)(ws + WS_YD);
    constexpr int KP2 = 72, VP2 = 24, SP2 = 72, CH = 16, NCH = SEQ / CH;
    constexpr int OPB_BYTES = 256 + 4 * 16 * KP2 * 2 + 3 * 64 * VP2 * 2;
    float* wl = (float*)smem;
    float* ybuf = wl + 1024;
    unsigned char* opb0 = smem + 8192;
    bf16_t* Sc = (bf16_t*)(opb0 + 2 * OPB_BYTES);
    const int tid = cx.tid, wv = tid >> 6, lane = tid & 63, l15 = lane & 15, g4 = lane >> 4;
    const bool is_prep = wv >= 4;
    const int j = lane, tq4 = wv - 4, it = wv;
    const int je = j & ~1; const bool jodd = (j & 1) != 0;
    const unsigned jsh = jodd ? 0u : 16u;
#define BSEL(W) __uint_as_float(((W) << jsh) & 0xffff0000u)
    for (int ci = cx.bx; ci < 2 * GBATCH * 8; ci += cx.gd) {
        const int dir = ci >> 7, bl = (ci >> 3) & 15, hh = ci & 7;
        const float kkw = (p->in[19] + l * 512)[hh * 64 + j], kaw = (p->in[20] + l * 512)[hh * 64 + j];
        __syncthreads();
        for (int idx = tid; idx < 64 * SP2 / 2; idx += NTHREADS) ((unsigned*)Sc)[idx] = 0u;
        f32x4 stS[4];
#pragma unroll
        for (int q = 0; q < 4; ++q) stS[q] = (f32x4){0.f, 0.f, 0.f, 0.f};
        unsigned xr[4], xk[4], xv[4], xu[4], xa[4]; float xn[4];
        float w_[4], kk_[4], kd_[4], bb_[4], r_[4]; unsigned vraw_[4];
#define SCAN_FETCH(C) { _Pragma("unroll") for (int e = 0; e < 4; ++e) { const int stp = (C) * CH + 4 * tq4 + e; const size_t tok = (size_t)bl * SEQ + (dir ? (SEQ - 1 - stp) : stp); \
            xr[e] = *(const unsigned*)(RKV + (tok * 3 + 0) * 512 + hh * 64 + je); xk[e] = *(const unsigned*)(RKV + (tok * 3 + 1) * 512 + hh * 64 + je); xv[e] = *(const unsigned*)(RKV + (tok * 3 + 2) * 512 + hh * 64 + je); \
            xu[e] = *(const unsigned*)(LOUT + tok * 2560 + dir * 512 + hh * 64 + je); xa[e] = *(const unsigned*)(LOUT + tok * 2560 + 1024 + dir * 512 + hh * 64 + je); xn[e] = KN[tok * 8 + hh]; } }
#define SCAN_DECODE() { _Pragma("unroll") for (int e = 0; e < 4; ++e) { const float kf = BSEL(xk[e]), af = BSEL(xa[e]); w_[e] = 1.0f - BSEL(xu[e]); kk_[e] = kf * kkw * xn[e]; kd_[e] = kf * (1.0f + (af - 1.0f) * kaw); bb_[e] = kk_[e] * af; \
            r_[e] = BSEL(xr[e]); vraw_[e] = (xv[e] << jsh) >> 16; } \
            wl[tq4 * 64 + j] = (w_[0] * w_[1]) * (w_[2] * w_[3]); }
#define SCAN_OPERANDS(BUF) { unsigned char* ob_ = opb0 + (BUF) * OPB_BYTES; float* pc_ = (float*)ob_; bf16_t* KKT_ = (bf16_t*)(ob_ + 256); bf16_t* RT_ = KKT_ + 16 * KP2; bf16_t* KDI_ = RT_ + 16 * KP2; bf16_t* BBI_ = KDI_ + 16 * KP2; \
            bf16_t* KDCT_ = BBI_ + 16 * KP2; bf16_t* NBBCT_ = KDCT_ + 64 * VP2; bf16_t* Vs_ = NBBCT_ + 64 * VP2; \
            float gp_[4]; \
            _Pragma("unroll") for (int gq = 0; gq < 4; ++gq) gp_[gq] = wl[gq * 64 + j]; \
            const float g01_ = gp_[0] * gp_[1]; const float pr = g01_ * (gp_[2] * gp_[3]); \
            const float pa = tq4 == 0 ? 1.0f : (tq4 == 1 ? gp_[0] : (tq4 == 2 ? g01_ : g01_ * gp_[2])); \
            float pprev = pa; \
            _Pragma("unroll") for (int e = 0; e < 4; ++e) { const int t = 4 * tq4 + e; const float ptv = pprev * w_[e]; const float ip = __builtin_amdgcn_rcpf(ptv); const float kdi = kd_[e] * ip, bbi = bb_[e] * ip; \
                const unsigned c1_ = pk2(kk_[e] * pprev, r_[e] * ptv), c2_ = pk2(kdi, bbi), c3_ = pk2(kdi * pr, -bbi * pr); \
                KKT_[t * KP2 + j] = (bf16_t)(c1_ & 0xffffu); RT_[t * KP2 + j] = (bf16_t)(c1_ >> 16); KDI_[t * KP2 + j] = (bf16_t)(c2_ & 0xffffu); BBI_[t * KP2 + j] = (bf16_t)(c2_ >> 16); \
                KDCT_[j * VP2 + t] = (bf16_t)(c3_ & 0xffffu); NBBCT_[j * VP2 + t] = (bf16_t)(c3_ >> 16); Vs_[j * VP2 + t] = (bf16_t)vraw_[e]; pprev = ptv; } \
            if (tq4 == 0) pc_[j] = pr; }
        if (is_prep) __builtin_amdgcn_s_setprio(2);
        if (is_prep) { SCAN_FETCH(0) SCAN_DECODE() }
        lds_barrier();
        if (is_prep) { SCAN_FETCH(1) SCAN_OPERANDS(0) }
        lds_barrier();
#pragma unroll 1
        for (int c = 0; c < NCH; ++c) {
            if (is_prep) {
                if (c + 1 < NCH) { SCAN_DECODE() }
                lds_barrier();
                if (c + 2 < NCH) { SCAN_FETCH(c + 2) }
                if (c + 1 < NCH) { SCAN_OPERANDS((c + 1) & 1) }
                lds_barrier();
                if (tid < 256 + 128) { const int t = (tid - 256) >> 3, ig = tid & 7; const int stp = c * CH + t; const size_t tok = (size_t)bl * SEQ + (dir ? (SEQ - 1 - stp) : stp);
                    const f32x4 y0 = *(const f32x4*)(ybuf + t * 64 + ig * 8), y1 = *(const f32x4*)(ybuf + t * 64 + ig * 8 + 4);
                    u32x4 o; o[0] = pk2(y0[0], y0[1]); o[1] = pk2(y0[2], y0[3]); o[2] = pk2(y1[0], y1[1]); o[3] = pk2(y1[2], y1[3]);
                    *(u32x4*)(YD + ((size_t)dir * TG + tok) * 512 + hh * 64 + ig * 8) = o; }
            } else {
                const unsigned char* ob = opb0 + (c & 1) * OPB_BYTES; const float* pc = (const float*)ob; const bf16_t* KKT = (const bf16_t*)(ob + 256); const bf16_t* RT = KKT + 16 * KP2;
                const bf16_t* KDI = RT + 16 * KP2; const bf16_t* BBI = KDI + 16 * KP2; const bf16_t* KDCT = BBI + 16 * KP2; const bf16_t* NBBCT = KDCT + 64 * VP2; const bf16_t* Vs = NBBCT + 64 * VP2;
                f32x4 M1 = (f32x4){0.f, 0.f, 0.f, 0.f}, M2 = M1, N1 = M1, N2 = M1, XK = M1, XR = M1, M2T = M1;
#pragma unroll
                for (int ks = 0; ks < 2; ++ks) { const int off = l15 * KP2 + ks * 32 + g4 * 8;
                    const bf16x8 kdif = *(const bf16x8*)(KDI + off), bbif = *(const bf16x8*)(BBI + off), kktf = *(const bf16x8*)(KKT + off), rtf = *(const bf16x8*)(RT + off);
                    const bf16x8 sf = *(const bf16x8*)(Sc + (16 * it + l15) * SP2 + ks * 32 + g4 * 8);
                    M1 = __builtin_amdgcn_mfma_f32_16x16x32_bf16(kdif, kktf, M1, 0, 0, 0); M2 = __builtin_amdgcn_mfma_f32_16x16x32_bf16(bbif, kktf, M2, 0, 0, 0);
                    M2T = __builtin_amdgcn_mfma_f32_16x16x32_bf16(kktf, bbif, M2T, 0, 0, 0);
                    N1 = __builtin_amdgcn_mfma_f32_16x16x32_bf16(kdif, rtf, N1, 0, 0, 0); N2 = __builtin_amdgcn_mfma_f32_16x16x32_bf16(bbif, rtf, N2, 0, 0, 0);
                    XK = __builtin_amdgcn_mfma_f32_16x16x32_bf16(kktf, sf, XK, 0, 0, 0); XR = __builtin_amdgcn_mfma_f32_16x16x32_bf16(rtf, sf, XR, 0, 0, 0); }
                const u32x2 vq = *(const u32x2*)(Vs + (16 * it + l15) * VP2 + 4 * g4);
                u32x2 kaq[4], kbq[4]; f32x4 pcv[4];
#pragma unroll
                for (int q = 0; q < 4; ++q) { const int jrow = 16 * q + l15; kaq[q] = *(const u32x2*)(KDCT + jrow * VP2 + 4 * g4); kbq[q] = *(const u32x2*)(NBBCT + jrow * VP2 + 4 * g4); pcv[q] = *(const f32x4*)(pc + 16 * q + 4 * g4); }
                lds_barrier();
#pragma unroll
                for (int r = 0; r < 4; ++r) { const int s = 4 * g4 + r; if (!(s < l15)) { M1[r] = 0.f; M2[r] = 0.f; } if (!(s <= l15)) { N1[r] = 0.f; N2[r] = 0.f; } if (!(l15 < s)) M2T[r] = 0.f; }
                const f32x4 Z4 = (f32x4){0.f, 0.f, 0.f, 0.f};
                f32x4 Id;
#pragma unroll
                for (int r = 0; r < 4; ++r) Id[r] = (4 * g4 + r == l15) ? 1.0f : 0.0f;
#define PK4(X) pack4z((X)[0], (X)[1], (X)[2], (X)[3])
#define MM(A_, B_) __builtin_amdgcn_mfma_f32_16x16x32_bf16(PK4(A_), PK4(B_), Z4, 0, 0, 0)
                const f32x4 P2 = MM(M2T, M2), P2T = MM(M2, M2T);
                const f32x4 P4 = MM(P2T, P2), P4T = MM(P2, P2T);
                const f32x4 P8 = MM(P4T, P4);
                const f32x4 a1 = Id + P4T, b1w = Id + P8, a2 = Id + P2, b2u = Id - M2T;
                const f32x4 Wm = MM(a1, b1w);
                const f32x4 UT = MM(a2, b2u);
                const f32x4 Tm = MM(UT, Wm);
#undef MM
                const bf16x8 AT = PK4(Tm);
                u32x4 b1; b1[0] = vq[0]; b1[1] = vq[1]; b1[2] = 0u; b1[3] = 0u;
                const f32x4 W1 = __builtin_amdgcn_mfma_f32_16x16x32_bf16(PK4(M1), __builtin_bit_cast(bf16x8, b1), XK, 0, 0, 0);
                const f32x4 SA = __builtin_amdgcn_mfma_f32_16x16x32_bf16(AT, PK4(W1), Z4, 0, 0, 0);
#undef PK4
                u32x4 bfq; bfq[0] = vq[0]; bfq[1] = vq[1]; bfq[2] = pk2(SA[0], SA[1]); bfq[3] = pk2(SA[2], SA[3]);
                const bf16x8 Bf = __builtin_bit_cast(bf16x8, bfq);
                { u32x4 a3; a3[0] = pk2(N1[0], N1[1]); a3[1] = pk2(N1[2], N1[3]); a3[2] = pk2(-N2[0], -N2[1]); a3[3] = pk2(-N2[2], -N2[3]);
                  const f32x4 Y = __builtin_amdgcn_mfma_f32_16x16x32_bf16(__builtin_bit_cast(bf16x8, a3), Bf, XR, 0, 0, 0);
#pragma unroll
                  for (int r = 0; r < 4; ++r) ybuf[(4 * g4 + r) * 64 + 16 * it + l15] = Y[r]; }
#pragma unroll
                for (int q = 0; q < 4; ++q) {
                    u32x4 a4; a4[0] = kaq[q][0]; a4[1] = kaq[q][1]; a4[2] = kbq[q][0]; a4[3] = kbq[q][1];
                    stS[q] = __builtin_amdgcn_mfma_f32_16x16x32_bf16(__builtin_bit_cast(bf16x8, a4), Bf, stS[q] * pcv[q], 0, 0, 0);
                    u32x2 sw; sw[0] = pk2(stS[q][0], stS[q][1]); sw[1] = pk2(stS[q][2], stS[q][3]);
                    *(u32x2*)(Sc + (16 * it + l15) * SP2 + 16 * q + 4 * g4) = sw; }
                lds_barrier();
            }
        }
        __builtin_amdgcn_s_setprio(0);
#undef SCAN_FETCH
#undef SCAN_DECODE
#undef SCAN_OPERANDS
    }
#undef BSEL
}

__device__ __forceinline__ void phase_rwpost(const Ctx cx, KP p, int l) {
    unsigned char* ws = p->ws;
    const bf16_t* __restrict__ RKV = (const bf16_t*)(ws + WS_RKV); const bf16_t* __restrict__ LOUT = (const bf16_t*)(ws + WS_LOUT); const bf16_t* __restrict__ YD = (const bf16_t*)(ws + WS_YD);
    bf16_t* __restrict__ YC = (bf16_t*)(ws + WS_YC);
    const int wv = cx.tid >> 6, lane = cx.tid & 63; const int ch = lane * 8;
    float ka[8], rk[8], lg[8], lb[8];
#pragma unroll
    for (int e = 0; e < 8; ++e) { ka[e] = (p->in[20] + l * 512)[ch + e]; rk[e] = (p->in[21] + l * 512)[ch + e]; lg[e] = (p->in[22] + l * 512)[ch + e]; lb[e] = (p->in[23] + l * 512)[ch + e]; }
    for (int r = cx.bx * 8 + wv; r < TG; r += cx.gd * 8) {
        const u32x4 q0 = *(const u32x4*)(YD + (size_t)r * 512 + ch), q1 = *(const u32x4*)(YD + ((size_t)TG + r) * 512 + ch);
        const u32x4 qr = *(const u32x4*)(RKV + ((size_t)r * 3 + 0) * 512 + ch), qk = *(const u32x4*)(RKV + ((size_t)r * 3 + 1) * 512 + ch), qv = *(const u32x4*)(RKV + ((size_t)r * 3 + 2) * 512 + ch);
        const u32x4 qa0 = *(const u32x4*)(LOUT + (size_t)r * 2560 + 1024 + ch), qa1 = *(const u32x4*)(LOUT + (size_t)r * 2560 + 1536 + ch), qg = *(const u32x4*)(LOUT + (size_t)r * 2560 + 2048 + ch);
        float y[8], bt = 0.f, sm = 0.f;
#pragma unroll
        for (int j = 0; j < 4; ++j) { y[2 * j] = bflo(q0[j]) + bflo(q1[j]); y[2 * j + 1] = bfhi(q0[j]) + bfhi(q1[j]); sm += y[2 * j] + y[2 * j + 1];
            bt += bflo(qr[j]) * bflo(qk[j]) * rk[2 * j] * (2.0f + (bflo(qa0[j]) + bflo(qa1[j]) - 2.0f) * ka[2 * j]);
            bt += bfhi(qr[j]) * bfhi(qk[j]) * rk[2 * j + 1] * (2.0f + (bfhi(qa0[j]) + bfhi(qa1[j]) - 2.0f) * ka[2 * j + 1]); }
        const float mean = red8(sm) * (1.0f / 64.0f); float sq = 0.f;
#pragma unroll
        for (int e = 0; e < 8; ++e) { y[e] -= mean; sq += y[e] * y[e]; }
        const float rs = rsqrtf(red8(sq) * (1.0f / 64.0f) + 64e-5f); const float bonus = red8(bt);
        u32x4 o;
#pragma unroll
        for (int j = 0; j < 4; ++j) o[j] = pk2((y[2 * j] * rs * lg[2 * j] + lb[2 * j] + bonus * bflo(qv[j])) * bflo(qg[j]), (y[2 * j + 1] * rs * lg[2 * j + 1] + lb[2 * j + 1] + bonus * bfhi(qv[j])) * bfhi(qg[j]));
        *(u32x4*)(YC + (size_t)r * 512 + ch) = o;
    }
}

__device__ __forceinline__ void phase_attn(const Ctx cx, KP p, unsigned char* smem) {
    unsigned char* ws = p->ws;
    const bf16_t* __restrict__ Q = (const bf16_t*)(ws + WS_Q); const bf16_t* __restrict__ KV = (const bf16_t*)(ws + WS_KV); const bf16_t* __restrict__ KR = (const bf16_t*)(ws + WS_KR); bf16_t* __restrict__ YA = (bf16_t*)(ws + WS_YA);
    constexpr int KP_ = 104, VTP = 72, BUFE = 64 * KP_ + 64 * VTP;
    bf16_t* lb = (bf16_t*)smem;
    const int tid = cx.tid, wv = tid >> 6, lane = tid & 63, l15 = lane & 15, g4 = lane >> 4;
    const int skey = tid >> 3, sch = tid & 7, skey2 = (tid & 255) >> 2, sch2 = tid & 3;
    const int vcol = skey ^ (sch << 3);
    for (int item0 = cx.bx; item0 < GBATCH * 8 * 8; item0 += cx.gd) {
        int item = item0;
        if (cx.gd == 256) { const int x = cx.bx & 7, li = (cx.bx >> 3) + 32 * (item0 >> 8); item = (((li >> 3) * 8 + x) << 3) | (li & 7); }
        const int qb = item & 7, hh = (item >> 3) & 7, bl = item >> 6;
        const size_t rb = (size_t)bl * SEQ; const size_t q0 = rb + qb * 256 + wv * 32;
        bf16x8 qf[2][3];
#pragma unroll
        for (int qt = 0; qt < 2; ++qt)
#pragma unroll
            for (int ks = 0; ks < 3; ++ks) qf[qt][ks] = *(const bf16x8*)(Q + (q0 + qt * 16 + l15) * 768 + hh * 96 + ks * 32 + g4 * 8);
        f32x4 o[2][4], osum[2]; float mrun[2] = {-1e30f, -1e30f};
        osum[0] = (f32x4){0.f, 0.f, 0.f, 0.f}; osum[1] = osum[0];
#pragma unroll
        for (int a = 0; a < 2; ++a)
#pragma unroll
            for (int b = 0; b < 4; ++b) o[a][b] = (f32x4){0.f, 0.f, 0.f, 0.f};
        u32x4 gk = *(const u32x4*)(KV + (rb + skey) * 1024 + hh * 128 + sch * 8);
        u32x4 gv = *(const u32x4*)(KV + (rb + skey) * 1024 + hh * 128 + 64 + sch * 8);
        u32x4 gr = *(const u32x4*)(KR + (rb + skey2) * 32 + sch2 * 8);
        __syncthreads();
#define ATT_STAGE(BUF) { bf16_t* Ks_ = lb + (BUF) * BUFE; bf16_t* Vt_ = Ks_ + 64 * KP_; \
            *(u32x4*)(Ks_ + skey * KP_ + sch * 8) = gk; if (tid < 256) *(u32x4*)(Ks_ + skey2 * KP_ + 64 + sch2 * 8) = gr; \
            _Pragma("unroll") for (int j = 0; j < 4; ++j) { Vt_[(sch * 8 + 2 * j) * VTP + vcol] = (bf16_t)(gv[j] & 0xffffu); Vt_[(sch * 8 + 2 * j + 1) * VTP + vcol] = (bf16_t)(gv[j] >> 16); } }
#define ATT_FETCH(KT) { const size_t kb = rb + (size_t)(KT) * 64; \
            gk = *(const u32x4*)(KV + (kb + skey) * 1024 + hh * 128 + sch * 8); gv = *(const u32x4*)(KV + (kb + skey) * 1024 + hh * 128 + 64 + sch * 8); \
            gr = *(const u32x4*)(KR + (kb + skey2) * 32 + sch2 * 8); }
        ATT_STAGE(0)
        ATT_FETCH(1)
        __syncthreads();
        for (int kt = 0; kt < SEQ / 64; ++kt) {
            if (kt + 1 < SEQ / 64) { ATT_STAGE((kt + 1) & 1) }
            if (kt + 2 < SEQ / 64) { ATT_FETCH(kt + 2) }
            const bf16_t* Ks = lb + (kt & 1) * BUFE; const bf16_t* Vt = Ks + 64 * KP_;
            f32x4 s[2][4];
#pragma unroll
            for (int a = 0; a < 2; ++a)
#pragma unroll
                for (int b = 0; b < 4; ++b) s[a][b] = (f32x4){0.f, 0.f, 0.f, 0.f};
#pragma unroll
            for (int k4 = 0; k4 < 4; ++k4)
#pragma unroll
                for (int ks = 0; ks < 3; ++ks) { const bf16x8 kf = *(const bf16x8*)(Ks + (k4 * 16 + l15) * KP_ + ks * 32 + g4 * 8);
#pragma unroll
                    for (int qt = 0; qt < 2; ++qt) s[qt][k4] = __builtin_amdgcn_mfma_f32_16x16x32_bf16(kf, qf[qt][ks], s[qt][k4], 0, 0, 0); }
            bf16x8 pf[2][2];
#pragma unroll
            for (int qt = 0; qt < 2; ++qt) {
                float mx = s[qt][0][0];
#pragma unroll
                for (int k4 = 0; k4 < 4; ++k4)
#pragma unroll
                    for (int j = 0; j < 4; ++j) mx = fmaxf(mx, s[qt][k4][j]);
                mx = max_swap32(max_swap16(mx));
                const float mn = fmaxf(mrun[qt], mx); const float al = __builtin_amdgcn_exp2f(mrun[qt] - mn); mrun[qt] = mn;
                unsigned pw[8];
#pragma unroll
                for (int k4 = 0; k4 < 4; ++k4) { float e[4];
#pragma unroll
                    for (int j = 0; j < 4; ++j) e[j] = __builtin_amdgcn_exp2f(s[qt][k4][j] - mn);
                    pw[k4 * 2] = pk2(e[0], e[1]); pw[k4 * 2 + 1] = pk2(e[2], e[3]); }
                if (__builtin_amdgcn_ballot_w64(al != 1.0f) != 0ull) {
#pragma unroll
                    for (int dt = 0; dt < 4; ++dt) o[qt][dt] *= al;
                    osum[qt] *= al; }
#pragma unroll
                for (int ks2 = 0; ks2 < 2; ++ks2) { u32x4 t; t[0] = pw[ks2 * 4]; t[1] = pw[ks2 * 4 + 1]; t[2] = pw[ks2 * 4 + 2]; t[3] = pw[ks2 * 4 + 3]; pf[qt][ks2] = __builtin_bit_cast(bf16x8, t); }
            }
            { u32x4 t1; const unsigned one2 = (l15 == 0) ? 0x3F803F80u : 0u; t1[0] = one2; t1[1] = one2; t1[2] = one2; t1[3] = one2; const bf16x8 vones = __builtin_bit_cast(bf16x8, t1);
#pragma unroll
              for (int ks2 = 0; ks2 < 2; ++ks2)
#pragma unroll
                  for (int qt = 0; qt < 2; ++qt) osum[qt] = __builtin_amdgcn_mfma_f32_16x16x32_bf16(vones, pf[qt][ks2], osum[qt], 0, 0, 0); }
#pragma unroll
            for (int dt = 0; dt < 4; ++dt) { const int vrow = (dt * 16 + l15) * VTP, vsw = (dt * 2 + (l15 >> 3)) << 3;
#pragma unroll
                for (int ks2 = 0; ks2 < 2; ++ks2) {
                    const u32x2 lo = *(const u32x2*)(Vt + vrow + (((2 * ks2) * 16 + g4 * 4) ^ vsw)), hi = *(const u32x2*)(Vt + vrow + (((2 * ks2 + 1) * 16 + g4 * 4) ^ vsw));
                    u32x4 t; t[0] = lo[0]; t[1] = lo[1]; t[2] = hi[0]; t[3] = hi[1]; const bf16x8 vf = __builtin_bit_cast(bf16x8, t);
#pragma unroll
                    for (int qt = 0; qt < 2; ++qt) o[qt][dt] = __builtin_amdgcn_mfma_f32_16x16x32_bf16(vf, pf[qt][ks2], o[qt][dt], 0, 0, 0); } }
            lds_barrier();
        }
#undef ATT_STAGE
#undef ATT_FETCH
#pragma unroll
        for (int qt = 0; qt < 2; ++qt) { const float lt = __shfl(osum[qt][0], l15); const float inv = 1.0f / lt;
#pragma unroll
            for (int dt = 0; dt < 4; ++dt) { u32x2 w; w[0] = pk2(o[qt][dt][0] * inv, o[qt][dt][1] * inv); w[1] = pk2(o[qt][dt][2] * inv, o[qt][dt][3] * inv);
                *(u32x2*)(YA + (q0 + qt * 16 + l15) * 512 + hh * 64 + dt * 16 + g4 * 4) = w; } }
    }
}

constexpr int NS = 19;
constexpr int N_PHASES = 1 + NL * NGRP * NS;
__device__ __forceinline__ bool stage_needs_sync(int st) { return !(st == 2 || st == 4 || st == 5 || st == 7 || st == 9 || st == 11 || st == 12); }

__global__ void __launch_bounds__(NTHREADS, 2) mega(Params pdummy) {
    extern __shared__ __attribute__((aligned(16))) unsigned char smem[];
    cg::grid_group grid = cg::this_grid();
    LAS unsigned char* lds = (LAS unsigned char*)smem;
    int ph_lo, ph_hi; XcdBarrier xbar;
    { KP p0 = get_kp(); ph_lo = p0->ph_lo; ph_hi = p0->ph_hi;
      volatile LAS unsigned* stw = (volatile LAS unsigned*)(lds + LDS_MAIN);
      if (threadIdx.x == 0) { stw[0] = 0u; stw[1] = 0u; }
      __syncthreads();
      xbar.bar = (unsigned*)(p0->ws + WS_BAR); xbar.x = xb_xcc_id(); xbar.st = stw;
      if (threadIdx.x == 0) (void)xb_add(&xbar.bar[XB_XCNT(xbar.x)], 1u); }
    bool repeated = false;
#pragma unroll 1
    for (int ph = ph_lo; ph < ph_hi;) {
        bool need_sync = true, again = false;
        Ctx cx; cx.tid = (int)threadIdx.x; cx.bx = (int)blockIdx.x; cx.gd = (int)gridDim.x; asm volatile("" : "+v"(cx.tid), "+s"(cx.bx), "+s"(cx.gd));
        const int G = cx.gd, bx = cx.bx;
        if (ph == 0) { KP p = get_kp(); phase_convert(cx, p, smem); }
        else {
            const int q = ph - 1; const int grp = q / (NL * NS), l = (q / NS) % NL, st = q % NS;
            need_sync = stage_needs_sync(st) && !(st == 18 && l != NL - 1);
            const size_t xoff = (size_t)grp * TG * 1024;
#define GETP KP p = get_kp(); unsigned char* ws = p->ws; (void)ws;
            if (REPEAT_MASK != 0 && ((REPEAT_MASK >> st) & 1) && !repeated) again = true;
            int ste = st; if ((st == 9 || st == 10) && ((bx >> 3) & 1)) ste = 19 - st;
            if ((st == 7 || st == 8) && ((bx >> 3) & 1)) ste = 15 - st;
            switch (ste) {
            case 0: { GETP
                if (l == 0) phase_rmsnorm(cx, p->in[0] + xoff, p->in[2] + l * 1024, (bf16_t*)(ws + WS_H), TG);
                else phase_rmsnorm_bf<false>(cx, (const bf16_t*)(ws + WS_XB), p->in[2] + l * 1024, (bf16_t*)(ws + WS_H), nullptr, TG); } break;
            case 1: { GETP
                pg8::Gemm g{(const bf16_t*)(ws + WS_H), (const bf16_t*)(ws + WS_WIN + l * SZ_WIN), TG, NPP, 1024, 1024}; pg8::StaticOrder S; S.init(TG, NPP, G, bx);
                pg8::EpiStore E{(bf16_t*)(ws + WS_P), NP, NP}; pg8::gemm_phase(cx, lds, g, S, E); } break;
            case 2: { GETP phase_prep(cx, p, l, grp); } break;
            case 3: { GETP phase_sg(cx, p, l, smem); } break;
            case 4: { GETP
                pg8::Gemm g{(const bf16_t*)(ws + WS_CQN), (const bf16_t*)(ws + WS_WUQ + l * SZ_WUQ), TG, 768, 384, 384}; pg8::StaticOrder S; S.init(TG, 768, G, bx);
                pg8::EpiQ E{(bf16_t*)(ws + WS_Q), (const float*)(ws + WS_CS)}; pg8::gemm_phase(cx, lds, g, S, E); } break;
            case 5: { GETP
                pg8::Gemm g{(const bf16_t*)(ws + WS_CKVN), (const bf16_t*)(ws + WS_WUKV + l * SZ_WUKV), TG, 1024, 256, 256}; pg8::StaticOrder S; S.init(TG, 1024, G, bx);
                pg8::EpiStore E{(bf16_t*)(ws + WS_KV), 1024, 1024}; pg8::gemm_phase(cx, lds, g, S, E);
                { pg8::Gemm g2{(const bf16_t*)(ws + WS_H), (const bf16_t*)(ws + WS_WKR + l * SZ_WKR), TG, 256, 1024, 1024}; pg8::StaticOrder S2; S2.init(TG, 256, G, (bx + G / 2) % G);
                  pg8::EpiKR E2{(bf16_t*)(ws + WS_KR), (const float*)(ws + WS_CS)}; pg8::gemm_phase(cx, lds, g2, S2, E2); } } break;
            case 6: { GETP
                { pg8::Gemm g{(const bf16_t*)(ws + WS_LIN), (const bf16_t*)(ws + WS_WLORA + l * SZ_WLORA), TG, 2048, 256, 384}; pg8::StaticOrder S; S.init(TG, 2048, G, bx);
                  pg8::EpiLora E{(bf16_t*)(ws + WS_LOUT), p->in[14] + l * 1024, p->in[16] + l * 1024, 0}; pg8::gemm_phase(cx, lds, g, S, E); }
                { pg8::Gemm g{(const bf16_t*)(ws + WS_LIN) + 128, (const bf16_t*)(ws + WS_WLORA + l * SZ_WLORA) + (size_t)2048 * 256, TG, 512, 256, 384}; pg8::StaticOrder S; S.init(TG, 512, G, bx);
                  pg8::EpiLora E{(bf16_t*)(ws + WS_LOUT), p->in[14] + l * 1024, p->in[16] + l * 1024, 2048}; pg8::gemm_phase(cx, lds, g, S, E); } } break;
            case 7: { GETP phase_scan(cx, p, l, smem); } break;
            case 8: { GETP phase_attn(cx, p, smem); } break;
            case 9: { GETP phase_rwpost(cx, p, l); } break;
            case 10: { GETP
                pg8::Gemm g{(const bf16_t*)(ws + WS_H), (const bf16_t*)(ws + WS_WG + l * SZ_WG), TG, 3072, 1024, 1024}; pg8::StaticOrder S; S.init(TG, 3072, G, bx);
                pg8::EpiGate E{(bf16_t*)(ws + WS_P), p->in[4] + l * 3072}; pg8::gemm_phase(cx, lds, g, S, E); } break;
            case 11: case 12: case 13: { GETP
                const int nb = st - 11;
                pg8::Gemm g{(const bf16_t*)(ws + WS_YA) + (size_t)nb * TG * 512, (const bf16_t*)(ws + WS_WBR + l * SZ_WBR) + (size_t)nb * 1024 * 512, TG, 1024, 512, 512};
                pg8::StaticOrder S; S.init(TG, 1024, G, bx); pg8::EpiBranch E{(bf16_t*)(ws + WS_KV), (const bf16_t*)(ws + WS_P), nb}; pg8::gemm_phase(cx, lds, g, S, E); } break;
            case 14: { GETP
                pg8::Gemm g{(const bf16_t*)(ws + WS_KV), (const bf16_t*)(ws + WS_WOUT + l * SZ_WOUT), TG, 1024, 1024, 1024}; pg8::StaticOrder S; S.init(TG, 1024, G, bx);
                if (l == 0) { pg8::EpiResidB<true> E{p->in[0] + xoff, nullptr, (bf16_t*)(ws + WS_XB)}; pg8::gemm_phase(cx, lds, g, S, E); }
                else { pg8::EpiResidB<false> E{nullptr, (const bf16_t*)(ws + WS_XB), (bf16_t*)(ws + WS_XB)}; pg8::gemm_phase(cx, lds, g, S, E); } } break;
            case 15: { GETP phase_rmsnorm_bf<false>(cx, (const bf16_t*)(ws + WS_XB), p->in[26] + l * 1024, (bf16_t*)(ws + WS_H), nullptr, TG); } break;
            case 16: { GETP
                pg8::Gemm g{(const bf16_t*)(ws + WS_H), (const bf16_t*)(ws + WS_WGU + l * SZ_WGU), TG, 5632, 1024, 1024}; pg8::StaticOrder S; S.init(TG, 5632, G, bx);
                pg8::EpiGU E{(bf16_t*)(ws + WS_P)}; pg8::gemm_phase(cx, lds, g, S, E); } break;
            case 17: { GETP
                pg8::Gemm g{(const bf16_t*)(ws + WS_P), (const bf16_t*)(ws + WS_WDN + l * SZ_WDN), TG, 1024, DFF, DFF}; pg8::StaticOrder S; S.init(TG, 1024, G, bx);
                pg8::EpiResidB<false> E{nullptr, (const bf16_t*)(ws + WS_XB), (bf16_t*)(ws + WS_XB)}; pg8::gemm_phase(cx, lds, g, S, E); } break;
            default: { GETP
                if (l == NL - 1) phase_rmsnorm_bf<true>(cx, (const bf16_t*)(ws + WS_XB), p->in[30], nullptr, p->out + xoff, TG); } break;
            }
        }
        if (again) { repeated = true; __syncthreads(); continue; }
        repeated = false;
        if (ph + 1 < ph_hi) { if (!need_sync) __syncthreads(); else if (ph == 0) grid.sync(); else xcd_barrier(xbar, cx.tid, (unsigned)cx.gd); }
        ++ph;
    }
}

extern "C" void kernel_launch(void* const* d_in, const int* in_sizes, int n_in, void* d_out, int out_size, void* d_ws, size_t ws_size, hipStream_t stream) {
    static int grid_blocks = 0;
    if (grid_blocks == 0) {
        if (n_in != 31 || out_size != TT * DM || ws_size < WS_END2) { fprintf(stderr, "kernel_launch: unexpected shapes (n_in %d out %d ws %zu need %zu)\n", n_in, out_size, ws_size, (size_t)WS_END2); grid_blocks = -1; return; }
        int dev = 0, cus = 0, per_cu = 0;
        hipGetDevice(&dev); hipDeviceGetAttribute(&cus, hipDeviceAttributeMultiprocessorCount, dev);
        if (hipFuncSetAttribute((const void*)mega, hipFuncAttributeMaxDynamicSharedMemorySize, LDS_BYTES) != hipSuccess) { fprintf(stderr, "kernel_launch: hipFuncSetAttribute failed\n"); grid_blocks = -1; return; }
        if (hipOccupancyMaxActiveBlocksPerMultiprocessor(&per_cu, (const void*)mega, NTHREADS, LDS_BYTES) != hipSuccess || per_cu < 1) { fprintf(stderr, "kernel_launch: occupancy query gave %d\n", per_cu); per_cu = 1; (void)hipGetLastError(); }
        grid_blocks = cus * per_cu;
    }
    if (grid_blocks < 0) return;
    Params p{};
    for (int i = 0; i < 31; ++i) p.in[i] = (const float*)d_in[i];
    p.out = (float*)d_out; p.ws = (unsigned char*)d_ws;
#if ONE_LAUNCH
    (void)hipMemsetAsync((unsigned char*)d_ws + WS_BAR, 0, XCD_BAR_WORDS_C * 4, stream);
    p.ph_lo = 0; p.ph_hi = N_PHASES;
    void* args[] = {&p};
    hipError_t e = hipLaunchCooperativeKernel((const void*)mega, dim3(grid_blocks), dim3(NTHREADS), args, LDS_BYTES, stream);
    if (e != hipSuccess) fprintf(stderr, "cooperative launch failed: %s (grid %d)\n", hipGetErrorString(e), grid_blocks);
#else
    for (int ph = 0; ph < N_PHASES; ++ph) { p.ph_lo = ph; p.ph_hi = ph + 1; hipLaunchKernelGGL(mega, dim3(grid_blocks), dim3(NTHREADS), LDS_BYTES, stream, p); }
#endif
}
```
